# Optimizing an MI355X kernel written in HIP

```python
import jax, jax.numpy as jnp
from jax import lax
import numpy as np

D_MODEL = 1024
BATCH = 16
SEQ = 2048
DEPTH = 2
DEC_BATCH = 32
DEC_SEQ = 64
PAST_LEN = 2048

CHUNK = 64
N_A_LAYERS = DEPTH // 2
N_B_LAYERS = DEPTH - N_A_LAYERS
D_RNN = D_MODEL
GATE_BLOCK = 256
N_GATE_BLOCKS = D_RNN // GATE_BLOCK
CONV_W = 4
LRU_C = 8.0
HEAD_DIM = 64
N_HEADS = D_MODEL // HEAD_DIM
N_KV = 2
GROUP = N_HEADS // N_KV
WINDOW = 128
WIN_CHUNKS = WINDOW // CHUNK
EPS = 1e-6
NEG = -1e30

kernel_name = "yoco_rglru_swa_sink_stream_step"


def _rmsnorm(x, g):
    xf = x.astype(jnp.float32)
    y = xf * lax.rsqrt(jnp.mean(xf * xf, axis=-1, keepdims=True) + EPS)
    return (y * g.astype(jnp.float32)).astype(x.dtype)


def _causal_conv(u, buf, w, b):
    t = u.shape[1]
    up = jnp.concatenate([buf.astype(u.dtype), u], axis=1)
    out = b
    for j in range(CONV_W):
        out = out + w[j] * up[:, j:j + t]
    return out, up[:, -(CONV_W - 1):]


def _block_diag(u, w, b):
    bsz, t, _ = u.shape
    ub = u.reshape(bsz, t, N_GATE_BLOCKS, GATE_BLOCK)
    return jnp.einsum('btnc,ncd->btnd', ub, w).reshape(bsz, t, D_RNN) + b


def _rglru(u, h0, w_gx, b_gx, w_ga, b_ga, lam):
    uf = u.astype(jnp.float32)
    i_t = jax.nn.sigmoid(_block_diag(u, w_gx, b_gx).astype(jnp.float32))
    r_t = jax.nn.sigmoid(_block_diag(u, w_ga, b_ga).astype(jnp.float32))
    log_a = LRU_C * r_t * jax.nn.log_sigmoid(lam.astype(jnp.float32))
    a = jnp.exp(log_a)
    mult = jnp.sqrt(-jnp.expm1(2.0 * log_a))
    bx = mult * i_t * uf
    bx = bx.at[:, 0].add(a[:, 0] * h0.astype(jnp.float32))

    def combine(l, r):
        return (l[0] * r[0], r[0] * l[1] + r[1])

    _, h = lax.associative_scan(combine, (a, bx), axis=1)
    return h, h[:, -1]


def _layer_a(x, conv_buf, h0, norm_g, w_in, cw, cb, w_gx, b_gx, w_ga, b_ga, lam, w_out):
    u = _rmsnorm(x, norm_g) @ w_in
    xb, gate = jnp.split(u, 2, axis=-1)
    xc, new_buf = _causal_conv(xb, conv_buf, cw, cb)
    h, h_last = _rglru(xc, h0, w_gx, b_gx, w_ga, b_ga, lam)
    y = (h * jax.nn.silu(gate.astype(jnp.float32))).astype(x.dtype) @ w_out
    return x + y, new_buf.astype(conv_buf.dtype), h_last.astype(h0.dtype)


def _shared_kv(x, norm_g, w_kv, k_norm):
    bsz, t, _ = x.shape
    kv = _rmsnorm(x, norm_g) @ w_kv
    k, v = jnp.split(kv, 2, axis=-1)
    k = _rmsnorm(k.reshape(bsz, t, N_KV, HEAD_DIM), k_norm)
    v = v.reshape(bsz, t, N_KV, HEAD_DIM)
    return k, v


def _sink_attention(q, k, v, sink, valid):
    s = jnp.einsum('bnqhgd,bnkhd->bnhgqk', q.astype(jnp.float32), k.astype(jnp.float32))
    s = s * (HEAD_DIM ** -0.5)
    s = jnp.where(valid[None, :, None, None, None, :], s, NEG)
    sk = sink.astype(jnp.float32).reshape(1, 1, N_KV, GROUP, 1, 1)
    m = jnp.maximum(jnp.max(s, axis=-1, keepdims=True), sk)
    p = jnp.exp(s - m)
    denom = jnp.sum(p, axis=-1, keepdims=True) + jnp.exp(sk - m)
    return jnp.einsum('bnhgqk,bnkhd->bnqhgd', p / denom, v.astype(jnp.float32))


def _band_attend(q, k, v, sink):
    bsz, s = q.shape[:2]
    nc = s // CHUNK
    qc = q.reshape(bsz, nc, CHUNK, N_KV, GROUP, HEAD_DIM)
    pad = ((0, 0), (WINDOW, 0), (0, 0), (0, 0))
    kp = jnp.pad(k, pad).reshape(bsz, nc + WIN_CHUNKS, CHUNK, N_KV, HEAD_DIM)
    vp = jnp.pad(v, pad).reshape(bsz, nc + WIN_CHUNKS, CHUNK, N_KV, HEAD_DIM)
    kb = jnp.concatenate([kp[:, j:j + nc] for j in range(WIN_CHUNKS + 1)], axis=2)
    vb = jnp.concatenate([vp[:, j:j + nc] for j in range(WIN_CHUNKS + 1)], axis=2)
    key_pos = (jnp.arange(nc)[:, None] * CHUNK
               + jnp.arange((WIN_CHUNKS + 1) * CHUNK)[None, :] - WINDOW)
    o = _sink_attention(qc, kb, vb, sink, key_pos >= 0)
    return o.reshape(bsz, s, N_HEADS * HEAD_DIM)


def _step_attend(q, k_all, v_all, sink):
    bsz, t = q.shape[:2]
    qc = q.reshape(bsz, 1, t, N_KV, GROUP, HEAD_DIM)
    valid = jnp.ones((1, k_all.shape[1]), dtype=bool)
    o = _sink_attention(qc, k_all[:, None], v_all[:, None], sink, valid)
    return o.reshape(bsz, t, N_HEADS * HEAD_DIM)


def _layer_b(x, k_att, v_att, is_prompt, norm_g, w_in, q_norm, sink, w_out):
    bsz, t, _ = x.shape
    u = _rmsnorm(x, norm_g) @ w_in
    q, gate = jnp.split(u, 2, axis=-1)
    q = _rmsnorm(q.reshape(bsz, t, N_HEADS, HEAD_DIM), q_norm)
    if is_prompt:
        o = _band_attend(q, k_att, v_att, sink)
    else:
        o = _step_attend(q, k_att, v_att, sink)
    y = (o * jax.nn.silu(gate.astype(jnp.float32))).astype(x.dtype) @ w_out
    return x + y


def _trunk(x, conv_state, h_state, k_cache, v_cache, is_prompt, params):
    (norm_a, w_in_a, conv_w, conv_b, w_gate_x, b_gate_x, w_gate_a, b_gate_a, lru_lambda,
     w_out_a, norm_kv, w_kv, k_norm, norm_b, w_in_b, q_norm, sinks, w_out_b) = params
    new_conv, new_h = [], []
    k_att = v_att = k_buf = v_buf = None
    for layer in range(DEPTH):
        if layer < N_A_LAYERS:
            i = layer
            x, cbuf, hl = _layer_a(x, conv_state[i], h_state[i], norm_a[i], w_in_a[i], conv_w[i],
                                   conv_b[i], w_gate_x[i], b_gate_x[i], w_gate_a[i], b_gate_a[i],
                                   lru_lambda[i], w_out_a[i])
            new_conv.append(cbuf)
            new_h.append(hl)
        else:
            if layer == N_A_LAYERS:
                k_new, v_new = _shared_kv(x, norm_kv, w_kv, k_norm)
                if is_prompt:
                    k_att, v_att = k_new, v_new
                else:
                    k_att = jnp.concatenate([k_cache.astype(k_new.dtype), k_new], axis=1)
                    v_att = jnp.concatenate([v_cache.astype(v_new.dtype), v_new], axis=1)
                k_buf, v_buf = k_att[:, -WINDOW:], v_att[:, -WINDOW:]
            j = layer - N_A_LAYERS
            x = _layer_b(x, k_att, v_att, is_prompt, norm_b[j], w_in_b[j], q_norm[j], sinks[j],
                         w_out_b[j])
    return x, jnp.stack(new_conv), jnp.stack(new_h), k_buf, v_buf


def setup_inputs(seed: int = 0) -> dict:
    key = jax.random.key(seed)
    ks = jax.random.split(key, 32)
    f32 = jnp.float32
    nrm = lambda k, shape, scale: jax.random.normal(k, shape, f32) * scale
    u = jax.random.uniform(ks[14], (N_A_LAYERS, D_RNN), f32, 0.9, 0.999)
    return {
        "x_prompt": nrm(ks[0], (BATCH, SEQ, D_MODEL), 1.0),
        "x_sample": nrm(ks[1], (DEC_BATCH, DEC_SEQ, D_MODEL), 1.0),
        "state_conv": nrm(ks[2], (N_A_LAYERS, DEC_BATCH, CONV_W - 1, D_RNN), 1.0),
        "state_rglru": nrm(ks[3], (N_A_LAYERS, DEC_BATCH, D_RNN), 0.5),
        "cache_k_win": nrm(ks[4], (DEC_BATCH, WINDOW, N_KV, HEAD_DIM), 1.0),
        "cache_v_win": nrm(ks[5], (DEC_BATCH, WINDOW, N_KV, HEAD_DIM), 1.0),
        "norm_a": 1.0 + nrm(ks[6], (N_A_LAYERS, D_MODEL), 0.02),
        "w_in_a": nrm(ks[7], (N_A_LAYERS, D_MODEL, 2 * D_RNN), D_MODEL ** -0.5),
        "conv_w": nrm(ks[8], (N_A_LAYERS, CONV_W, D_RNN), CONV_W ** -0.5),
        "conv_b": nrm(ks[9], (N_A_LAYERS, D_RNN), 0.02),
        "w_gate_x": nrm(ks[10], (N_A_LAYERS, N_GATE_BLOCKS, GATE_BLOCK, GATE_BLOCK), GATE_BLOCK ** -0.5),
        "b_gate_x": nrm(ks[11], (N_A_LAYERS, D_RNN), 0.02),
        "w_gate_a": nrm(ks[12], (N_A_LAYERS, N_GATE_BLOCKS, GATE_BLOCK, GATE_BLOCK), GATE_BLOCK ** -0.5),
        "b_gate_a": nrm(ks[13], (N_A_LAYERS, D_RNN), 0.02),
        "lru_lambda": jnp.log(u) - jnp.log1p(-u),
        "w_out_a": nrm(ks[15], (N_A_LAYERS, D_RNN, D_MODEL), D_RNN ** -0.5),
        "norm_kv": 1.0 + nrm(ks[16], (D_MODEL,), 0.02),
        "w_kv": nrm(ks[17], (D_MODEL, 2 * N_KV * HEAD_DIM), D_MODEL ** -0.5),
        "k_norm": 1.0 + nrm(ks[18], (HEAD_DIM,), 0.02),
        "norm_b": 1.0 + nrm(ks[19], (N_B_LAYERS, D_MODEL), 0.02),
        "w_in_b": nrm(ks[20], (N_B_LAYERS, D_MODEL, 2 * N_HEADS * HEAD_DIM), D_MODEL ** -0.5),
        "q_norm": 1.0 + nrm(ks[21], (N_B_LAYERS, HEAD_DIM), 0.02),
        "sinks": nrm(ks[22], (N_B_LAYERS, N_HEADS), 0.5),
        "w_out_b": nrm(ks[23], (N_B_LAYERS, N_HEADS * HEAD_DIM, D_MODEL), (N_HEADS * HEAD_DIM) ** -0.5),
    }


def reference(x_prompt, x_sample, state_conv, state_rglru, cache_k_win, cache_v_win,
              norm_a, w_in_a, conv_w, conv_b, w_gate_x, b_gate_x, w_gate_a, b_gate_a, lru_lambda,
              w_out_a, norm_kv, w_kv, k_norm, norm_b, w_in_b, q_norm, sinks, w_out_b):
    params = (norm_a, w_in_a, conv_w, conv_b, w_gate_x, b_gate_x, w_gate_a, b_gate_a, lru_lambda,
              w_out_a, norm_kv, w_kv, k_norm, norm_b, w_in_b, q_norm, sinks, w_out_b)
    bp = x_prompt.shape[0]
    conv0 = jnp.zeros((N_A_LAYERS, bp, CONV_W - 1, D_RNN), x_prompt.dtype)
    h0 = jnp.zeros((N_A_LAYERS, bp, D_RNN), x_prompt.dtype)
    y_prompt, conv_p, h_p, k_p, v_p = _trunk(x_prompt, conv0, h0, None, None, True, params)
    y_sample, conv_s, h_s, k_s, v_s = _trunk(x_sample, state_conv, state_rglru, cache_k_win,
                                             cache_v_win, False, params)
    return (y_prompt, y_sample, conv_p, h_p, k_p, v_p, conv_s, h_s, k_s, v_s)
```

```cpp
#include <hip/hip_runtime.h>
#include <hip/hip_cooperative_groups.h>
#include <cstdio>
#include <cstdint>
namespace cg = cooperative_groups;

#ifndef MK_SINGLE
#define MK_SINGLE 1
#endif

namespace pg8 {
#define PG8_LAS __attribute__((address_space(3)))
typedef unsigned short bf16_t;
typedef short bf16x8 __attribute__((ext_vector_type(8)));
typedef float f32x4 __attribute__((ext_vector_type(4)));
typedef unsigned u32x4 __attribute__((ext_vector_type(4)));
constexpr int BM = 256, BK = 64, HALF = 128, HTB = HALF * BK * 2  , STAGE_BYTES = 8 * HTB, NXCD = 8, WGM = 8;

__host__ __device__ __forceinline__ int lds_byte(int r, int c) { const int st = (r >> 4) * 2 + (c >> 5), rr = r & 15, cc = c & 31, ob = rr * 64 + cc * 2; return st * 1024 + (ob ^ (((ob >> 9) & 1) << 5)); }
__host__ __device__ __forceinline__ void stage_rc(int b, int& R, int& C) { const int st = b / 1024, sb = b % 1024, swz = sb ^ (((sb >> 9) & 1) << 5); R = (st >> 1) * 16 + swz / 64; C = (st & 1) * 32 + (swz % 64) / 2; }
__host__ __device__ __forceinline__ int perm32(int rho) { const int n = rho >> 4, i = rho & 15; return 8 * (i >> 2) + 4 * n + (i & 3); }

struct Unit { int pm, pn; };
struct Gemm { const bf16_t* A; const bf16_t* Bt; int M, N, K, lda, ldb, apn_shift, apn_elems; };

struct StaticOrder {
    int nM, nN, nwg, G, c;
    __host__ __device__ void init(int M, int N, int G_, int c_) { nM = M / BM; nN = N / BM; nwg = nM * nN; G = G_; c = c_; }
    __host__ __device__ bool next(int i, Unit& u) const {
        const long L = (long)i * G + c; if (L >= nwg) return false;
        int wgid = (int)L; { const int q = nwg / NXCD, r = nwg % NXCD, xcd = wgid % NXCD, off = wgid / NXCD; wgid = (xcd < r ? xcd * (q + 1) : r * (q + 1) + (xcd - r) * q) + off; }
        const int nig = WGM * nN, gid = wgid / nig, fm = gid * WGM, gsz = (nM - fm) < WGM ? (nM - fm) : WGM;
        u.pm = fm + ((wgid % nig) % gsz); u.pn = (wgid % nig) / gsz; return true;
    }
};

__device__ __forceinline__ unsigned cvt_pk_bf16(float lo, float hi) { unsigned r; asm volatile("v_cvt_pk_bf16_f32 %0, %1, %2" : "=v"(r) : "v"(lo), "v"(hi)); return r; }

template <class Epi, class Sched, bool ALIGN_EPI>
__device__ __forceinline__ void gemm_phase(PG8_LAS unsigned char* lds, const Gemm g, const Sched& S, const Epi& E) {
    const int tid = threadIdx.x, wid = __builtin_amdgcn_readfirstlane(tid >> 6), lane = tid & 63, wr = wid >> 2, wc = wid & 3, fr = lane & 15, fq = lane >> 4;
    const int K = g.K, nt = K / BK;
    unsigned voffA[2], voffB[2];
#pragma unroll
    for (int i = 0; i < 2; ++i) { int R, C; stage_rc(tid * 16 + i * 8192, R, C); const int Rb = Epi::PERM ? ((R & ~31) + perm32(R & 31)) : R;
        voffA[i] = (unsigned)(R * g.lda + C) * 2u; voffB[i] = (unsigned)(Rb * g.ldb + C) * 2u; }
    const size_t kstep = (size_t)(BK * 2);
    const size_t hstepA = (size_t)HALF * g.lda * 2, hstepB = (size_t)HALF * g.ldb * 2;
    const size_t tstepA = 2 * hstepA, tstepB = 2 * hstepB;
    const unsigned ldsw = (unsigned)wid * 1024u;
    const int aoff = lds_byte(wr * 64 + fr, fq * 8), boff = lds_byte(wc * 32 + fr, fq * 8);
#define PG8_SA(b, h) (((b) * 2 + (h)) * HTB)
#define PG8_SB(b, h) ((4 + (b) * 2 + (h)) * HTB)
#define PG8_STAGE(bufoff, gbase, voff) do { _Pragma("unroll") for (int _i = 0; _i < 2; ++_i) \
        __builtin_amdgcn_global_load_lds((const unsigned*)((const char*)(gbase) + (voff)[_i]), (PG8_LAS unsigned*)(lds + (bufoff) + ldsw + _i * 8192), 16, 0, 0); } while (0)
#define PG8_LDA(dst, b, h) do { _Pragma("unroll") for (int m = 0; m < 4; ++m) _Pragma("unroll") for (int k = 0; k < 2; ++k) dst[m][k] = *(const PG8_LAS bf16x8*)(lds + PG8_SA(b, h) + aoff + m * 2048 + k * 1024); } while (0)
#define PG8_LDB(dst, b, h) do { _Pragma("unroll") for (int n = 0; n < 2; ++n) _Pragma("unroll") for (int k = 0; k < 2; ++k) dst[n][k] = *(const PG8_LAS bf16x8*)(lds + PG8_SB(b, h) + boff + n * 2048 + k * 1024); } while (0)
#define PG8_MMA(ai, bj, At, Bt) do { __builtin_amdgcn_s_setprio(1); _Pragma("unroll") for (int m = 0; m < 4; ++m) _Pragma("unroll") for (int n = 0; n < 2; ++n) _Pragma("unroll") for (int k = 0; k < 2; ++k) \
        acc[ai][bj][m][n] = __builtin_amdgcn_mfma_f32_16x16x32_bf16(Bt[n][k], At[m][k], acc[ai][bj][m][n], 0, 0, 0); __builtin_amdgcn_s_setprio(0); } while (0)
#define PG8_WAIT_V(n) asm volatile("s_waitcnt vmcnt(" #n ")" ::: "memory")
#define PG8_WAIT_L(n) asm volatile("s_waitcnt lgkmcnt(" #n ")" ::: "memory")
#define PG8_BAR __builtin_amdgcn_s_barrier()
#define PG8_SCHED __builtin_amdgcn_sched_barrier(0)
#define PG8_AOFF(u) ((size_t)(((u).pn >> g.apn_shift) * g.apn_elems) * 2)
    Unit cur, nxt; int ui = 0;
    if (!S.next(0, cur)) return;
    f32x4 acc[2][2][4][2];
#pragma unroll
    for (int a = 0; a < 2; ++a)
#pragma unroll
        for (int b = 0; b < 2; ++b)
#pragma unroll
            for (int m = 0; m < 4; ++m)
#pragma unroll
                for (int n = 0; n < 2; ++n) acc[a][b][m][n] = (f32x4){0.f, 0.f, 0.f, 0.f};
    bf16x8 At[4][2], B0[2][2], B1[2][2];
    const char* cA = (const char*)g.A + (size_t)cur.pm * tstepA + PG8_AOFF(cur); const char* cB = (const char*)g.Bt + (size_t)cur.pn * tstepB;
    PG8_STAGE(PG8_SB(0, 0), cB, voffB); PG8_STAGE(PG8_SB(0, 1), cB + hstepB, voffB); PG8_STAGE(PG8_SA(0, 0), cA, voffA); PG8_STAGE(PG8_SA(0, 1), cA + hstepA, voffA);
    if (wr == 1) PG8_BAR;
    PG8_WAIT_V(2); PG8_BAR;
    PG8_STAGE(PG8_SB(1, 0), cB + kstep, voffB); PG8_STAGE(PG8_SA(1, 0), cA + kstep, voffA); PG8_STAGE(PG8_SB(1, 1), cB + hstepB + kstep, voffB);
    PG8_WAIT_V(6); PG8_BAR;
    for (;;) {
        const bool has_next = S.next(ui + 1, nxt);
        const char* nA = has_next ? (const char*)g.A + (size_t)nxt.pm * tstepA + PG8_AOFF(nxt) : cA; const char* nB = has_next ? (const char*)g.Bt + (size_t)nxt.pn * tstepB : cB;
        for (int t = 0; t < nt; t += 2) {
            const bool last = (t == nt - 2);
            const char* a1 = cA + (size_t)(t + 1) * kstep;
            const char* a2 = last ? nA : cA + (size_t)(t + 2) * kstep; const char* b2 = last ? nB : cB + (size_t)(t + 2) * kstep;
            const char* a3 = a2 + kstep; const char* b3 = b2 + kstep;
            PG8_LDB(B0, 0, 0); PG8_LDB(B1, 0, 1); PG8_SCHED; PG8_LDA(At, 0, 0); PG8_STAGE(PG8_SA(1, 1), a1 + hstepA, voffA);
            PG8_WAIT_V(8); PG8_WAIT_L(0); PG8_BAR; PG8_MMA(0, 0, At, B0); PG8_MMA(0, 1, At, B1); PG8_BAR; PG8_SCHED;
            PG8_LDA(At, 0, 1); PG8_STAGE(PG8_SB(0, 0), b2, voffB); PG8_STAGE(PG8_SB(0, 1), b2 + hstepB, voffB); PG8_STAGE(PG8_SA(0, 0), a2, voffA);
            PG8_WAIT_V(8); PG8_WAIT_L(0); PG8_BAR; PG8_MMA(1, 0, At, B0); PG8_MMA(1, 1, At, B1); PG8_BAR; PG8_SCHED;
            PG8_LDB(B0, 1, 0); PG8_LDB(B1, 1, 1); PG8_SCHED; PG8_LDA(At, 1, 0); PG8_STAGE(PG8_SA(0, 1), a2 + hstepA, voffA);
            PG8_WAIT_V(8); PG8_WAIT_L(0); PG8_BAR; PG8_MMA(0, 0, At, B0); PG8_MMA(0, 1, At, B1); PG8_BAR; PG8_SCHED;
            PG8_LDA(At, 1, 1); PG8_STAGE(PG8_SB(1, 0), b3, voffB); PG8_STAGE(PG8_SB(1, 1), b3 + hstepB, voffB); PG8_STAGE(PG8_SA(1, 0), a3, voffA);
            PG8_WAIT_V(8); PG8_WAIT_L(0); PG8_BAR; PG8_MMA(1, 0, At, B0); PG8_MMA(1, 1, At, B1); PG8_BAR; PG8_SCHED;
        }
        if constexpr (ALIGN_EPI) { if (wr == 0) PG8_BAR; }
        E(acc, cur, wr, wc, fr, fq);
        if (!has_next) break;
#pragma unroll
        for (int a = 0; a < 2; ++a)
#pragma unroll
            for (int b = 0; b < 2; ++b)
#pragma unroll
                for (int m = 0; m < 4; ++m)
#pragma unroll
                    for (int n = 0; n < 2; ++n) acc[a][b][m][n] = (f32x4){0.f, 0.f, 0.f, 0.f};
        cur = nxt; cA = nA; cB = nB; ++ui;
        if constexpr (ALIGN_EPI) { if (wr == 1) PG8_BAR; }
    }
    PG8_WAIT_V(0);
    if constexpr (!ALIGN_EPI) { if (wr == 0) PG8_BAR; }
    PG8_BAR;
#undef PG8_SA
#undef PG8_SB
#undef PG8_STAGE
#undef PG8_LDA
#undef PG8_LDB
#undef PG8_MMA
#undef PG8_WAIT_V
#undef PG8_WAIT_L
#undef PG8_BAR
#undef PG8_SCHED
#undef PG8_AOFF
}
}

#define LAS __attribute__((address_space(3)))
typedef unsigned short bf16_t;
typedef unsigned v4u __attribute__((ext_vector_type(4)));
typedef unsigned v2u __attribute__((ext_vector_type(2)));
typedef float f32x4 __attribute__((ext_vector_type(4)));
typedef short bf16x8 __attribute__((ext_vector_type(8)));

constexpr int D = 1024, TP = 2048, TS = 64, NBP = 16, NBS = 32;
constexpr int MP = NBP * TP;
constexpr int MS = NBS * TS;
constexpr int M = MP + MS;
constexpr float EPS = 1e-6f;
constexpr size_t O_Y = 0, O_CONVP = 35651584, O_HP = 35700736, O_KP = 35717120, O_VP = 35979264, O_CONVS = 36241408, O_HS = 36339712, O_KS = 36372480, O_VS = 36896768;
constexpr size_t MiB = 1u << 20;
constexpr size_t WS_WINA = 1 * MiB, WS_WGATE = 5 * MiB, WS_WOUTA = 6 * MiB, WS_WB = 8 * MiB, WS_WOUTB = 13 * MiB, WS_SS = 15 * MiB, WS_CP = 16 * MiB, WS_CH = 19 * MiB,
                 WS_KC = 22 * MiB, WS_VTC = 23 * MiB, WS_VTS = 24 * MiB, WS_KB = 25 * MiB, WS_VTP = 34 * MiB, WS_R1 = 48 * MiB, WS_R2 = 116 * MiB, WS_R3 = 252 * MiB, WS_END = 388 * MiB;
constexpr int LDS_BYTES = 135168;
constexpr int NPH = 10;

__device__ __forceinline__ unsigned pk2(float lo, float hi) { return pg8::cvt_pk_bf16(lo, hi); }
__device__ __forceinline__ float bflo(unsigned w) { return __uint_as_float(w << 16); }
__device__ __forceinline__ float bfhi(unsigned w) { return __uint_as_float(w & 0xffff0000u); }
__device__ __forceinline__ float bf2f(bf16_t b) { return __uint_as_float((unsigned)b << 16); }
__device__ __forceinline__ float sigmoidf_(float x) { return __builtin_amdgcn_rcpf(1.0f + __expf(-x)); }
__device__ __forceinline__ float wave_sum(float v) {
#pragma unroll
    for (int o = 1; o < 64; o <<= 1) v += __shfl_xor(v, o);
    return v;
}

using pg8::Unit;
struct EpiStore {
    static constexpr bool PERM = true;
    bf16_t* O; int ldc;
    __device__ __forceinline__ void operator()(const f32x4 (&acc)[2][2][4][2], const Unit& u, int wr, int wc, int fr_, int fq_) const {
        int fr = fr_, fq = fq_; asm volatile("" : "+v"(fr), "+v"(fq));
        const int row0 = u.pm * 256 + wr * 64 + fr, col0 = u.pn * 256 + wc * 32 + 8 * fq;
#pragma unroll
        for (int ai = 0; ai < 2; ++ai)
#pragma unroll
            for (int m = 0; m < 4; ++m) { bf16_t* rowp = O + (size_t)(row0 + ai * 128 + m * 16) * ldc + col0;
#pragma unroll
                for (int bj = 0; bj < 2; ++bj) { const f32x4 v0 = acc[ai][bj][m][0], v1 = acc[ai][bj][m][1];
                    v4u w; w.x = pk2(v0[0], v0[1]); w.y = pk2(v0[2], v0[3]); w.z = pk2(v1[0], v1[1]); w.w = pk2(v1[2], v1[3]);
                    *(v4u*)(rowp + bj * 128) = w; } }
    }
};
struct EpiGate {
    static constexpr bool PERM = true;
    const bf16_t* XC; const float* bgx; const float* bga; const float* lam; unsigned* AB;
    __device__ __forceinline__ void operator()(const f32x4 (&acc)[2][2][4][2], const Unit& u, int wr, int wc, int fr_, int fq_) const {
        int fr = fr_, fq = fq_; asm volatile("" : "+v"(fr), "+v"(fq));
        const int row0 = u.pm * 256 + wr * 64 + fr, ch0 = u.pn * 128 + wc * 32 + 8 * fq;
#pragma unroll
        for (int ai = 0; ai < 2; ++ai)
#pragma unroll
            for (int m = 0; m < 4; ++m) { const size_t off = (size_t)(row0 + ai * 128 + m * 16) * D + ch0;
                asm volatile("" ::: "memory");
                const v4u xw = *(const v4u*)(XC + off);
                float xc[8] = {bflo(xw.x), bfhi(xw.x), bflo(xw.y), bfhi(xw.y), bflo(xw.z), bfhi(xw.z), bflo(xw.w), bfhi(xw.w)};
#pragma unroll
                for (int n = 0; n < 2; ++n) { const f32x4 t0 = *(const f32x4*)(bgx + ch0 + 4 * n), t1 = *(const f32x4*)(bga + ch0 + 4 * n), t2 = *(const f32x4*)(lam + ch0 + 4 * n);
                    unsigned ow[4];
#pragma unroll
                    for (int e = 0; e < 4; ++e) {
                        const float ig = sigmoidf_(acc[ai][0][m][n][e] + t0[e]);
                        const float rg = sigmoidf_(acc[ai][1][m][n][e] + t1[e]);
                        const float la = t2[e] * rg;
                        const float a = __expf(la);
                        const float mult = sqrtf(fmaxf(1.0f - a * a, 0.f));
                        const float bxv = mult * ig * xc[4 * n + e];
                        const _Float16 lh = (_Float16)la;
                        ow[e] = (unsigned)__builtin_bit_cast(unsigned short, lh) | (pk2(bxv, bxv) & 0xffff0000u); }
                    *(v4u*)(AB + off + 4 * n) = (v4u){ow[0], ow[1], ow[2], ow[3]};
                    __builtin_amdgcn_sched_barrier(0); } }
    }
};
struct EpiOutA {
    static constexpr bool PERM = true;
    const float* xp; const float* xs; float* X1; bf16_t* X1B; float* SS;
    __device__ __forceinline__ void operator()(const f32x4 (&acc)[2][2][4][2], const Unit& u, int wr, int wc, int fr_, int fq_) const {
        int fr = fr_, fq = fq_; asm volatile("" : "+v"(fr), "+v"(fq));
        const int row0 = u.pm * 256 + wr * 64 + fr, col0 = u.pn * 256 + wc * 32 + 8 * fq;
#pragma unroll
        for (int ai = 0; ai < 2; ++ai)
#pragma unroll
            for (int m = 0; m < 4; ++m) { const int row = row0 + ai * 128 + m * 16;
                asm volatile("" ::: "memory");
                const float* xr = (row < MP) ? xp + (size_t)row * D : xs + (size_t)(row - MP) * D;
                float ssq = 0.f;
#pragma unroll
                for (int bj = 0; bj < 2; ++bj) { const int c = col0 + bj * 128;
                    const f32x4 v0 = acc[ai][bj][m][0] + *(const f32x4*)(xr + c), v1 = acc[ai][bj][m][1] + *(const f32x4*)(xr + c + 4);
                    *(f32x4*)(X1 + (size_t)row * D + c) = v0; *(f32x4*)(X1 + (size_t)row * D + c + 4) = v1;
                    v4u w; w.x = pk2(v0[0], v0[1]); w.y = pk2(v0[2], v0[3]); w.z = pk2(v1[0], v1[1]); w.w = pk2(v1[2], v1[3]);
                    *(v4u*)(X1B + (size_t)row * D + c) = w;
                    ssq += (v0[0] * v0[0] + v0[1] * v0[1]) + (v0[2] * v0[2] + v0[3] * v0[3]) + (v1[0] * v1[0] + v1[1] * v1[1]) + (v1[2] * v1[2] + v1[3] * v1[3]); }
                ssq += __shfl_xor(ssq, 16); ssq += __shfl_xor(ssq, 32);
                if (fq == 0) atomicAdd(SS + row, ssq); }
    }
};
struct EpiB {
    static constexpr bool PERM = true;
    const float* SS; const float* qg; const float* kg; bf16_t* QB; bf16_t* GB; bf16_t* KB; bf16_t* VTP; bf16_t* VTS; float* out;
    __device__ __forceinline__ void operator()(const f32x4 (&acc)[2][2][4][2], const Unit& u, int wr, int wc, int fr_, int fq_) const {
        int fr = fr_, fq = fq_; asm volatile("" : "+v"(fr), "+v"(fq));
        const int Hd = 4 * u.pn + wc, row0 = u.pm * 256 + wr * 64 + fr;
        const bool normed = (Hd < 16) || (Hd == 32) || (Hd == 33);
        const float* gsrc = (Hd < 16) ? qg : kg; const float gscale = (Hd < 16) ? 0.125f : 1.0f;
#pragma unroll
        for (int ai = 0; ai < 2; ++ai)
#pragma unroll
            for (int m = 0; m < 4; ++m) { const int row = row0 + ai * 128 + m * 16;
                asm volatile("" ::: "memory");
                const float rs = rsqrtf(SS[row] * (1.0f / D) + EPS);
                float v[2][8];
#pragma unroll
                for (int bj = 0; bj < 2; ++bj)
#pragma unroll
                    for (int n = 0; n < 2; ++n)
#pragma unroll
                        for (int e = 0; e < 4; ++e) v[bj][4 * n + e] = acc[ai][bj][m][n][e] * rs;
                if (normed) {
                    float ssq = 0.f;
#pragma unroll
                    for (int bj = 0; bj < 2; ++bj)
#pragma unroll
                        for (int e = 0; e < 8; ++e) ssq += v[bj][e] * v[bj][e];
                    ssq += __shfl_xor(ssq, 16); ssq += __shfl_xor(ssq, 32);
                    const float hn = rsqrtf(ssq * (1.0f / 64.0f) + EPS) * gscale;
#pragma unroll
                    for (int bj = 0; bj < 2; ++bj) { const f32x4 g0 = *(const f32x4*)(gsrc + 32 * bj + 8 * fq), g1 = *(const f32x4*)(gsrc + 32 * bj + 8 * fq + 4);
#pragma unroll
                        for (int e = 0; e < 4; ++e) { v[bj][e] *= hn * g0[e]; v[bj][4 + e] *= hn * g1[e]; } }
                }
                if (Hd < 32) {
                    if (Hd >= 16) {
#pragma unroll
                        for (int bj = 0; bj < 2; ++bj)
#pragma unroll
                            for (int e = 0; e < 8; ++e) v[bj][e] = v[bj][e] * sigmoidf_(v[bj][e]);
                    }
                    bf16_t* dst = ((Hd < 16) ? QB : GB) + (size_t)row * D + (Hd & 15) * 64 + 8 * fq;
#pragma unroll
                    for (int bj = 0; bj < 2; ++bj) { v4u w; w.x = pk2(v[bj][0], v[bj][1]); w.y = pk2(v[bj][2], v[bj][3]); w.z = pk2(v[bj][4], v[bj][5]); w.w = pk2(v[bj][6], v[bj][7]);
                        *(v4u*)(dst + 32 * bj) = w; }
                } else {
                    const int h = Hd & 1; const bool isv = Hd >= 34;
                    float* od = nullptr; int sq, t;
                    if (row < MP) { sq = row >> 11; t = row & 2047; if (t >= TP - 128) od = out + (isv ? O_VP : O_KP) + ((size_t)(sq * 128 + (t - (TP - 128))) * 2 + h) * 64; }
                    else { sq = (row - MP) >> 6; t = (row - MP) & 63; od = out + (isv ? O_VS : O_KS) + ((size_t)(sq * 128 + 64 + t) * 2 + h) * 64; }
                    if (od) {
#pragma unroll
                        for (int bj = 0; bj < 2; ++bj) { float* p = od + 32 * bj + 8 * fq;
                            *(f32x4*)p = (f32x4){v[bj][0], v[bj][1], v[bj][2], v[bj][3]}; *(f32x4*)(p + 4) = (f32x4){v[bj][4], v[bj][5], v[bj][6], v[bj][7]}; }
                    }
                    if (!isv) {
                        bf16_t* dst = KB + (size_t)row * 128 + h * 64 + 8 * fq;
#pragma unroll
                        for (int bj = 0; bj < 2; ++bj) { v4u w; w.x = pk2(v[bj][0], v[bj][1]); w.y = pk2(v[bj][2], v[bj][3]); w.z = pk2(v[bj][4], v[bj][5]); w.w = pk2(v[bj][6], v[bj][7]);
                            *(v4u*)(dst + 32 * bj) = w; }
                    } else {
                        bf16_t* vb; int pitch;
                        if (row < MP) { vb = VTP + (size_t)((sq * 2 + h) * 64) * TP + t; pitch = TP; } else { vb = VTS + (size_t)((sq * 2 + h) * 64) * TS + t; pitch = TS; }
#pragma unroll
                        for (int bj = 0; bj < 2; ++bj)
#pragma unroll
                            for (int e = 0; e < 8; ++e) vb[(size_t)(32 * bj + 8 * fq + e) * pitch] = (bf16_t)(pk2(v[bj][e], v[bj][e]) & 0xffffu);
                    }
                }
            }
    }
};
struct EpiOutB {
    static constexpr bool PERM = true;
    float* Y;
    __device__ __forceinline__ void operator()(const f32x4 (&acc)[2][2][4][2], const Unit& u, int wr, int wc, int fr_, int fq_) const {
        int fr = fr_, fq = fq_; asm volatile("" : "+v"(fr), "+v"(fq));
        const int row0 = u.pm * 256 + wr * 64 + fr, col0 = u.pn * 256 + wc * 32 + 8 * fq;
#pragma unroll
        for (int ai = 0; ai < 2; ++ai)
#pragma unroll
            for (int m = 0; m < 4; ++m) { float* yr = Y + (size_t)(row0 + ai * 128 + m * 16) * D + col0;
                asm volatile("" ::: "memory");
#pragma unroll
                for (int bj = 0; bj < 2; ++bj) { float* p = yr + bj * 128;
                    const f32x4 v0 = acc[ai][bj][m][0] + *(const f32x4*)p, v1 = acc[ai][bj][m][1] + *(const f32x4*)(p + 4);
                    *(f32x4*)p = v0; *(f32x4*)(p + 4) = v1; } }
    }
};

struct RmId { __device__ __forceinline__ int operator()(int n) const { return n; } };
struct RmGate { int g, isA; __device__ __forceinline__ int operator()(int n) const { return 256 * (2 * g + (n >> 7)) + (n & 127) + (isA ? 128 : 0); } };
struct RmHead { int head0; __device__ __forceinline__ int operator()(int n) const { const int H = head0 + (n >> 6), j = n & 63; return 256 * (H >> 2) + 128 * (j >> 5) + 32 * (H & 3) + (j & 31); } };
template <class RM>
__device__ __forceinline__ void transpose_item(const float* W, int ldw, int nblk, const float* gain, bf16_t* WT, int ldt, const RM rm, LAS float* scr, int item, int lane) {
    const int kb = item / nblk, nb = item % nblk, k0 = 64 * kb, n0 = 32 * nb;
#pragma unroll 8
    for (int i = 0; i < 32; ++i) { const int kk = 2 * i + (lane >> 5); const float gsc = gain ? gain[k0 + kk] : 1.0f; scr[kk * 33 + (lane & 31)] = W[(size_t)(k0 + kk) * ldw + n0 + (lane & 31)] * gsc; }
    asm volatile("s_waitcnt lgkmcnt(0)" ::: "memory");
    const int c = lane & 7;
#pragma unroll
    for (int j = 0; j < 4; ++j) { const int n = (lane >> 3) + 8 * j; const LAS float* s = scr + (8 * c) * 33 + n;
        v4u o; o.x = pk2(s[0 * 33], s[1 * 33]); o.y = pk2(s[2 * 33], s[3 * 33]); o.z = pk2(s[4 * 33], s[5 * 33]); o.w = pk2(s[6 * 33], s[7 * 33]);
        *(v4u*)(WT + (size_t)rm(n0 + n) * ldt + k0 + 8 * c) = o; }
    asm volatile("s_waitcnt lgkmcnt(0)" ::: "memory");
}

struct Args { const float* in[24]; float* out; unsigned char* ws; int ph_lo, ph_hi; };

__global__ void __launch_bounds__(512, 2) yoco_fwd(Args args) {
    extern __shared__ __attribute__((aligned(16))) unsigned char lds_raw[];
    LAS unsigned char* lds = (LAS unsigned char*)lds_raw;
    const int tid = threadIdx.x, lane = tid & 63, wave = __builtin_amdgcn_readfirstlane(tid >> 6);
    const int G = gridDim.x, bid = blockIdx.x;
    const int gw = bid * 8 + wave, NGW = G * 8;
    const int gtid = bid * 512 + tid, NT = G * 512;
    unsigned char* ws = args.ws; float* out = args.out;
typedef const float* cfp_t;
#define ARGP(k) (((cfp_t const volatile __attribute__((address_space(4)))*)__builtin_amdgcn_kernarg_segment_ptr())[k])
    bf16_t* WT_INA = (bf16_t*)(ws + WS_WINA); bf16_t* WT_GATE = (bf16_t*)(ws + WS_WGATE); bf16_t* WT_OUTA = (bf16_t*)(ws + WS_WOUTA);
    bf16_t* WT_B = (bf16_t*)(ws + WS_WB); bf16_t* WT_OUTB = (bf16_t*)(ws + WS_WOUTB);
    float* SS = (float*)(ws + WS_SS); float* CL = (float*)(ws + WS_SS + 512 * 1024); float* CP = (float*)(ws + WS_CP); float* CH = (float*)(ws + WS_CH);
    bf16_t* KC = (bf16_t*)(ws + WS_KC); bf16_t* VTC = (bf16_t*)(ws + WS_VTC); bf16_t* VTS = (bf16_t*)(ws + WS_VTS);
    bf16_t* KB = (bf16_t*)(ws + WS_KB); bf16_t* VTP = (bf16_t*)(ws + WS_VTP);
    bf16_t* XN = (bf16_t*)(ws + WS_R1); bf16_t* XC = XN; bf16_t* HG = XN;
    bf16_t* U = (bf16_t*)(ws + WS_R2); bf16_t* X1B = U;
    unsigned* AB = (unsigned*)(ws + WS_R3); bf16_t* QB = (bf16_t*)(ws + WS_R3); bf16_t* GB = QB + (size_t)M * D;
    const int lo = args.ph_lo, hi = args.ph_hi;
#ifdef ONLYPH
#define IN(k) ((k) == ONLYPH && lo <= (k) && (k) < hi)
#else
#define IN(k) (lo <= (k) && (k) < hi)
#endif
#if MK_SINGLE
#define SEAM(k) do { if (IN(k) && IN((k) + 1)) cg::this_grid().sync(); } while (0)
#else
#define SEAM(k) do { } while (0)
#endif

    if (IN(0)) {
        const float* xp = ARGP(0); const float* xs = ARGP(1); const float* cache_k = ARGP(4); const float* cache_v = ARGP(5); const float* norm_a = ARGP(6); const float* w_in_a = ARGP(7);
        const float* w_gx = ARGP(10); const float* w_ga = ARGP(12); const float* lam = ARGP(14); const float* w_out_a = ARGP(15); const float* norm_kv = ARGP(16); const float* w_kv = ARGP(17);
        const float* norm_b = ARGP(19); const float* w_in_b = ARGP(20); const float* w_out_b = ARGP(23);
        LAS float* scr = (LAS float*)(lds + wave * 16384);
        constexpr int NITEMS = 1024 + 256 + 512 + 1024 + 128 + 512;
        for (int it = gw; it < NITEMS; it += NGW) {
            int r = it;
            if (r < 1024) { transpose_item(w_in_a, 2048, 64, norm_a, WT_INA, 1024, RmId{}, scr, r, lane); continue; } r -= 1024;
            if (r < 256) { const int gm = r >> 5, gi = gm & 3, isA = gm >> 2; transpose_item((isA ? w_ga : w_gx) + (size_t)gi * 65536, 256, 8, nullptr, WT_GATE, 256, RmGate{gi, isA}, scr, r & 31, lane); continue; } r -= 256;
            if (r < 512) { transpose_item(w_out_a, 1024, 32, nullptr, WT_OUTA, 1024, RmId{}, scr, r, lane); continue; } r -= 512;
            if (r < 1024) { transpose_item(w_in_b, 2048, 64, norm_b, WT_B, 1024, RmHead{0}, scr, r, lane); continue; } r -= 1024;
            if (r < 128) { transpose_item(w_kv, 256, 8, norm_kv, WT_B, 1024, RmHead{32}, scr, r, lane); continue; } r -= 128;
            transpose_item(w_out_b, 1024, 32, nullptr, WT_OUTB, 1024, RmId{}, scr, r, lane);
        }
        for (int m = gw; m < M; m += NGW) {
            const float* xrow = (m < MP) ? xp + (size_t)m * D : xs + (size_t)(m - MP) * D;
            const f32x4* xr = (const f32x4*)xrow + lane;
            f32x4 v[4]; float s = 0.f;
#pragma unroll
            for (int j = 0; j < 4; ++j) { v[j] = xr[64 * j]; s += (v[j].x * v[j].x + v[j].y * v[j].y) + (v[j].z * v[j].z + v[j].w * v[j].w); }
            const float rs = rsqrtf(wave_sum(s) * (1.0f / D) + EPS);
            v2u* o8 = (v2u*)(XN + (size_t)m * D) + lane;
#pragma unroll
            for (int j = 0; j < 4; ++j) o8[64 * j] = (v2u){pk2(v[j].x * rs, v[j].y * rs), pk2(v[j].z * rs, v[j].w * rs)};
        }
        for (int i = gtid; i < M; i += NT) SS[i] = 0.f;
        for (int i = gtid; i < D; i += NT) { const float l = lam[i]; CL[i] = 8.0f * (fminf(l, 0.f) - log1pf(__expf(-fabsf(l)))); }
        for (int i = gtid; i < NBS * 128 * 128; i += NT) { KC[i] = (bf16_t)(pk2(cache_k[i], 0.f) & 0xffffu);
            const int t = i & 127, d = (i >> 7) & 63, h = (i >> 13) & 1, b = i >> 14;
            VTC[i] = (bf16_t)(pk2(cache_v[((size_t)(b * 128 + t) * 2 + h) * 64 + d], 0.f) & 0xffffu); }
        for (int i = gtid; i < NBS * 64 * 128; i += NT) { const int b = i >> 13, rem = i & 8191;
            out[O_KS + (size_t)b * 16384 + rem] = cache_k[(size_t)b * 16384 + 8192 + rem];
            out[O_VS + (size_t)b * 16384 + rem] = cache_v[(size_t)b * 16384 + 8192 + rem]; }
        __syncthreads();
    }
    SEAM(0);

    if (IN(1)) {
        pg8::Gemm g{XN, WT_INA, M, 2048, 1024, 1024, 1024, 0, 0}; pg8::StaticOrder S; S.init(M, 2048, G, bid);
        EpiStore E{U, 2048};
        pg8::gemm_phase<EpiStore, pg8::StaticOrder, true>(lds, g, S, E);
    }
    SEAM(1);

    if (IN(2)) {
        const float* state_conv = ARGP(2); const float* conv_w = ARGP(8); const float* conv_b = ARGP(9);
        for (int it = gw; it < (M / 16) * 2; it += NGW) {
            const int row0 = (it >> 1) * 16, c0 = (it & 1) * 512 + lane * 8;
            int t0, T; const float* st = nullptr; float* cso;
            if (row0 < MP) { t0 = row0 & 2047; T = TP; cso = out + O_CONVP + (size_t)(row0 >> 11) * 3 * D; }
            else { const int r = row0 - MP; t0 = r & 63; T = TS; st = state_conv + (size_t)(r >> 6) * 3 * D; cso = out + O_CONVS + (size_t)(r >> 6) * 3 * D; }
            float w[4][8], bb[8], xh[3][8];
#pragma unroll
            for (int e = 0; e < 8; ++e) { bb[e] = conv_b[c0 + e];
#pragma unroll
                for (int j = 0; j < 4; ++j) w[j][e] = conv_w[j * D + c0 + e]; }
#pragma unroll
            for (int j = 0; j < 3; ++j) {
                if (t0 == 0) {
#pragma unroll
                    for (int e = 0; e < 8; ++e) xh[j][e] = st ? st[j * D + c0 + e] : 0.f;
                } else {
                    const v4u q = *(const v4u*)(U + (size_t)(row0 - 3 + j) * 2048 + c0);
                    xh[j][0] = bflo(q.x); xh[j][1] = bfhi(q.x); xh[j][2] = bflo(q.y); xh[j][3] = bfhi(q.y); xh[j][4] = bflo(q.z); xh[j][5] = bfhi(q.z); xh[j][6] = bflo(q.w); xh[j][7] = bfhi(q.w);
                }
            }
#pragma unroll
            for (int r = 0; r < 16; ++r) {
                const v4u q = *(const v4u*)(U + (size_t)(row0 + r) * 2048 + c0);
                float x3[8] = {bflo(q.x), bfhi(q.x), bflo(q.y), bfhi(q.y), bflo(q.z), bfhi(q.z), bflo(q.w), bfhi(q.w)};
                float o[8];
#pragma unroll
                for (int e = 0; e < 8; ++e) o[e] = bb[e] + w[0][e] * xh[0][e] + w[1][e] * xh[1][e] + w[2][e] * xh[2][e] + w[3][e] * x3[e];
                *(v4u*)(XC + (size_t)(row0 + r) * D + c0) = (v4u){pk2(o[0], o[1]), pk2(o[2], o[3]), pk2(o[4], o[5]), pk2(o[6], o[7])};
                if (t0 + r >= T - 3) { float* p = cso + (size_t)(t0 + r - (T - 3)) * D + c0;
                    *(f32x4*)p = (f32x4){x3[0], x3[1], x3[2], x3[3]}; *(f32x4*)(p + 4) = (f32x4){x3[4], x3[5], x3[6], x3[7]}; }
#pragma unroll
                for (int e = 0; e < 8; ++e) { xh[0][e] = xh[1][e]; xh[1][e] = xh[2][e]; xh[2][e] = x3[e]; }
            }
        }
        __syncthreads();
    }
    SEAM(2);

    if (IN(3)) {
        pg8::Gemm g{XC, WT_GATE, M, 2048, 256, 1024, 256, 1, 256}; pg8::StaticOrder S; S.init(M, 2048, G, bid);
        EpiGate E{XC, ARGP(11), ARGP(13), CL, AB};
        pg8::gemm_phase<EpiGate, pg8::StaticOrder, true>(lds, g, S, E);
    }
    SEAM(3);

    if (IN(4)) {
        for (int it = gw; it < (M / 64) * 16; it += NGW) {
            const int uid = it >> 4, c = (it & 15) * 64 + lane;
            const unsigned* p = AB + (size_t)uid * 64 * D + c;
            float P = 1.f, H = 0.f;
#pragma unroll 1
            for (int r0 = 0; r0 < 64; r0 += 16) {
                unsigned wv[16];
#pragma unroll
                for (int i = 0; i < 16; ++i) wv[i] = p[(size_t)(r0 + i) * D];
#pragma unroll
                for (int i = 0; i < 16; ++i) { const float la = (float)__builtin_bit_cast(_Float16, (unsigned short)(wv[i] & 0xffffu)); const float a = __expf(la);
                    P *= a; H = a * H + bfhi(wv[i]); }
            }
            CP[(size_t)uid * D + c] = P; CH[(size_t)uid * D + c] = H;
        }
        __syncthreads();
    }
    SEAM(4);

    if (IN(5)) {
        const float* state_h = ARGP(3);
        for (int it = gw; it < (M / 64) * 16; it += NGW) {
            const int uid = it >> 4, c = (it & 15) * 64 + lane;
            int k; float h;
            if (uid < 512) { k = uid & 31; h = 0.f; } else { k = 0; h = state_h[(size_t)(uid - 512) * D + c]; }
            for (int j = 0; j < k; ++j) { const size_t o = (size_t)(uid - k + j) * D + c; h = CP[o] * h + CH[o]; }
            const unsigned* p = AB + (size_t)uid * 64 * D + c;
            const bf16_t* gp = U + (size_t)uid * 64 * 2048 + 1024 + c;
            bf16_t* hp = HG + (size_t)uid * 64 * D + c;
#pragma unroll 1
            for (int r0 = 0; r0 < 64; r0 += 16) {
                unsigned wv[16]; bf16_t gv[16];
#pragma unroll
                for (int i = 0; i < 16; ++i) { wv[i] = p[(size_t)(r0 + i) * D]; gv[i] = gp[(size_t)(r0 + i) * 2048]; }
#pragma unroll
                for (int i = 0; i < 16; ++i) { const float la = (float)__builtin_bit_cast(_Float16, (unsigned short)(wv[i] & 0xffffu)); const float a = __expf(la);
                    h = a * h + bfhi(wv[i]); const float gt = bf2f(gv[i]); const float hg = h * gt * sigmoidf_(gt);
                    hp[(size_t)(r0 + i) * D] = (bf16_t)(pk2(hg, hg) & 0xffffu); }
            }
            if (uid >= 512) out[O_HS + (size_t)(uid - 512) * D + c] = h;
            else if (k == 31) out[O_HP + (size_t)(uid >> 5) * D + c] = h;
        }
        __syncthreads();
    }
    SEAM(5);

    if (IN(6)) {
        pg8::Gemm g{HG, WT_OUTA, M, 1024, 1024, 1024, 1024, 0, 0}; pg8::StaticOrder S; S.init(M, 1024, G, bid);
        EpiOutA E{ARGP(0), ARGP(1), out + O_Y, X1B, SS};
        pg8::gemm_phase<EpiOutA, pg8::StaticOrder, true>(lds, g, S, E);
    }
    SEAM(6);

    if (IN(7)) {
        pg8::Gemm g{X1B, WT_B, M, 2304, 1024, 1024, 1024, 0, 0}; pg8::StaticOrder S; S.init(M, 2304, G, bid);
        EpiB E{SS, ARGP(21), ARGP(18), QB, GB, KB, VTP, VTS, out};
        pg8::gemm_phase<EpiB, pg8::StaticOrder, true>(lds, g, S, E);
    }
    SEAM(7);

    if (IN(8)) {
        const float* sinks = ARGP(22);
        const int i16 = lane & 15, g4 = lane >> 4;
        for (int u = bid; u < 1088; u += G) {
            int row0, kvh; const bf16_t* kp[3]; const bf16_t* vp[3]; int vpitch[3]; bool valid[3];
            if (u < 1024) { const int s = u >> 6, c = (u >> 1) & 31; kvh = u & 1; row0 = s * TP + 64 * c;
#pragma unroll
                for (int jb = 0; jb < 3; ++jb) { const int cc = c - 2 + jb; valid[jb] = cc >= 0; const int ccc = cc < 0 ? 0 : cc;
                    kp[jb] = KB + (size_t)(s * TP + 64 * ccc) * 128 + kvh * 64; vp[jb] = VTP + (size_t)((s * 2 + kvh) * 64) * TP + 64 * ccc; vpitch[jb] = TP; }
            } else { const int u2 = u - 1024, b = u2 >> 1; kvh = u2 & 1; row0 = MP + 64 * b;
#pragma unroll
                for (int jb = 0; jb < 2; ++jb) { valid[jb] = true; kp[jb] = KC + (size_t)(b * 128 + 64 * jb) * 128 + kvh * 64; vp[jb] = VTC + (size_t)((b * 2 + kvh) * 64) * 128 + 64 * jb; vpitch[jb] = 128; }
                valid[2] = true; kp[2] = KB + (size_t)(MP + 64 * b) * 128 + kvh * 64; vp[2] = VTS + (size_t)((b * 2 + kvh) * 64) * TS; vpitch[2] = TS;
            }
            const int qh = kvh * 8 + wave; const float sk = sinks[qh];
#pragma unroll 1
            for (int qt = 0; qt < 4; ++qt) {
                const size_t qoff = (size_t)(row0 + 16 * qt + i16) * D + qh * 64;
                const bf16x8 qf0 = *(const bf16x8*)(QB + qoff + 8 * g4), qf1 = *(const bf16x8*)(QB + qoff + 32 + 8 * g4);
                f32x4 s[12];
#pragma unroll
                for (int jb = 0; jb < 3; ++jb) {
                    if (valid[jb]) {
#pragma unroll
                        for (int q2 = 0; q2 < 4; ++q2) { const int sb = q2 >> 1, par = q2 & 1;
                            const int kk = 32 * sb + 8 * (i16 >> 2) + (i16 & 3) + 4 * par;
                            const bf16_t* kptr = kp[jb] + (size_t)kk * 128 + 8 * g4;
                            const bf16x8 a0 = *(const bf16x8*)kptr, a1 = *(const bf16x8*)(kptr + 32);
                            f32x4 ac = (f32x4){0.f, 0.f, 0.f, 0.f};
                            ac = __builtin_amdgcn_mfma_f32_16x16x32_bf16(a0, qf0, ac, 0, 0, 0);
                            ac = __builtin_amdgcn_mfma_f32_16x16x32_bf16(a1, qf1, ac, 0, 0, 0);
                            s[4 * jb + q2] = ac; }
                    } else {
#pragma unroll
                        for (int q2 = 0; q2 < 4; ++q2) s[4 * jb + q2] = (f32x4){-1e30f, -1e30f, -1e30f, -1e30f};
                    }
                }
                float mx = sk;
#pragma unroll
                for (int kt = 0; kt < 12; ++kt) mx = fmaxf(fmaxf(mx, fmaxf(s[kt][0], s[kt][1])), fmaxf(s[kt][2], s[kt][3]));
                mx = fmaxf(mx, __shfl_xor(mx, 16)); mx = fmaxf(mx, __shfl_xor(mx, 32));
                float sum = 0.f;
#pragma unroll
                for (int kt = 0; kt < 12; ++kt) {
#pragma unroll
                    for (int r = 0; r < 4; ++r) { const float pv = __expf(s[kt][r] - mx); s[kt][r] = pv; sum += pv; } }
                sum += __shfl_xor(sum, 16); sum += __shfl_xor(sum, 32);
                const float inv = 1.0f / (sum + __expf(sk - mx));
                bf16x8 pf[6];
#pragma unroll
                for (int kb = 0; kb < 6; ++kb) { const f32x4 p0 = s[2 * kb] * inv, p1 = s[2 * kb + 1] * inv;
                    const v4u w = (v4u){pk2(p0[0], p0[1]), pk2(p0[2], p0[3]), pk2(p1[0], p1[1]), pk2(p1[2], p1[3])};
                    pf[kb] = __builtin_bit_cast(bf16x8, w); }
                const size_t ooff = (size_t)(row0 + 16 * qt + i16) * D + qh * 64 + 4 * g4;
#pragma unroll
                for (int dt = 0; dt < 4; ++dt) {
                    f32x4 oc = (f32x4){0.f, 0.f, 0.f, 0.f};
#pragma unroll
                    for (int jb = 0; jb < 3; ++jb) {
                        if (valid[jb]) {
#pragma unroll
                            for (int sb = 0; sb < 2; ++sb) {
                                const bf16x8 vf = *(const bf16x8*)(vp[jb] + (size_t)(16 * dt + i16) * vpitch[jb] + 32 * sb + 8 * g4);
                                oc = __builtin_amdgcn_mfma_f32_16x16x32_bf16(vf, pf[2 * jb + sb], oc, 0, 0, 0); }
                        }
                    }
                    const v2u gw2 = *(const v2u*)(GB + ooff + 16 * dt);
                    *(v2u*)(HG + ooff + 16 * dt) = (v2u){pk2(oc[0] * bflo(gw2.x), oc[1] * bfhi(gw2.x)), pk2(oc[2] * bflo(gw2.y), oc[3] * bfhi(gw2.y))};
                }
            }
        }
        __syncthreads();
    }
    SEAM(8);

    if (IN(9)) {
        pg8::Gemm g{HG, WT_OUTB, M, 1024, 1024, 1024, 1024, 0, 0}; pg8::StaticOrder S; S.init(M, 1024, G, bid);
        EpiOutB E{out + O_Y};
        pg8::gemm_phase<EpiOutB, pg8::StaticOrder, true>(lds, g, S, E);
    }
#undef IN
#undef SEAM
}

extern "C" void kernel_launch(void* const* d_in, const int* in_sizes, int n_in, void* d_out, int out_size, void* d_ws, size_t ws_size, hipStream_t stream) {
    static int grid = 0;
    if (grid == 0) {
        if (n_in != 24 || ws_size < WS_END) { fprintf(stderr, "kernel_launch: unexpected n_in %d / ws %zu\n", n_in, ws_size); grid = -1; return; }
        int dev = 0, cus = 0, per_cu = 0;
        (void)hipGetDevice(&dev);
        (void)hipDeviceGetAttribute(&cus, hipDeviceAttributeMultiprocessorCount, dev);
        if (hipFuncSetAttribute((const void*)yoco_fwd, hipFuncAttributeMaxDynamicSharedMemorySize, LDS_BYTES) != hipSuccess) { fprintf(stderr, "kernel_launch: hipFuncSetAttribute failed\n"); }
        if (hipOccupancyMaxActiveBlocksPerMultiprocessor(&per_cu, (const void*)yoco_fwd, 512, LDS_BYTES) != hipSuccess || per_cu < 1) { fprintf(stderr, "kernel_launch: occupancy query gave %d\n", per_cu); per_cu = 1; }
        (void)hipGetLastError();
        if (per_cu > 1) per_cu = 1;
        grid = cus * per_cu;
    }
    if (grid < 0) return;
    Args a{};
    for (int i = 0; i < 24; ++i) a.in[i] = (const float*)d_in[i];
    a.out = (float*)d_out; a.ws = (unsigned char*)d_ws;
#if MK_SINGLE
    a.ph_lo = 0; a.ph_hi = NPH;
    void* kargs[] = {&a};
    hipError_t e = hipLaunchCooperativeKernel((const void*)yoco_fwd, dim3(grid), dim3(512), kargs, LDS_BYTES, stream);
    if (e != hipSuccess) fprintf(stderr, "cooperative launch failed: %s (grid %d)\n", hipGetErrorString(e), grid);
#else
    for (int ph = 0; ph < NPH; ++ph) {
        a.ph_lo = ph; a.ph_hi = ph + 1;
        hipLaunchKernelGGL(yoco_fwd, dim3(grid), dim3(512), LDS_BYTES, stream, a);
    }
#endif
}
```

```cpp
#include <hip/hip_runtime.h>
#include <hip/hip_cooperative_groups.h>
#include <cstdio>
#include <cstdint>
namespace cg = cooperative_groups;

#ifndef MK_SINGLE
#define MK_SINGLE 1
#endif

namespace pg8 {
#define PG8_LAS __attribute__((address_space(3)))
typedef unsigned short bf16_t;
typedef short bf16x8 __attribute__((ext_vector_type(8)));
typedef float f32x4 __attribute__((ext_vector_type(4)));
typedef unsigned u32x4 __attribute__((ext_vector_type(4)));
constexpr int BM = 256, BK = 64, HALF = 128, HTB = HALF * BK * 2  , STAGE_BYTES = 8 * HTB, NXCD = 8, WGM = 8;

__host__ __device__ __forceinline__ int lds_byte(int r, int c) { const int st = (r >> 4) * 2 + (c >> 5), rr = r & 15, cc = c & 31, ob = rr * 64 + cc * 2; return st * 1024 + (ob ^ (((ob >> 9) & 1) << 5)); }
__host__ __device__ __forceinline__ void stage_rc(int b, int& R, int& C) { const int st = b / 1024, sb = b % 1024, swz = sb ^ (((sb >> 9) & 1) << 5); R = (st >> 1) * 16 + swz / 64; C = (st & 1) * 32 + (swz % 64) / 2; }
__host__ __device__ __forceinline__ int perm32(int rho) { const int n = rho >> 4, i = rho & 15; return 8 * (i >> 2) + 4 * n + (i & 3); }

struct Unit { int pm, pn; };
struct Gemm { const bf16_t* A; const bf16_t* Bt; int M, N, K, lda, ldb, apn_shift, apn_elems; };

struct StaticOrder {
    int nM, nN, nwg, G, c;
    __host__ __device__ void init(int M, int N, int G_, int c_) { nM = M / BM; nN = N / BM; nwg = nM * nN; G = G_; c = c_; }
    __host__ __device__ bool next(int i, Unit& u) const {
        const long L = (long)i * G + c; if (L >= nwg) return false;
        int wgid = (int)L; { const int q = nwg / NXCD, r = nwg % NXCD, xcd = wgid % NXCD, off = wgid / NXCD; wgid = (xcd < r ? xcd * (q + 1) : r * (q + 1) + (xcd - r) * q) + off; }
        const int nig = WGM * nN, gid = wgid / nig, fm = gid * WGM, gsz = (nM - fm) < WGM ? (nM - fm) : WGM;
        u.pm = fm + ((wgid % nig) % gsz); u.pn = (wgid % nig) / gsz; return true;
    }
};

__device__ __forceinline__ unsigned cvt_pk_bf16(float lo, float hi) { unsigned r; asm volatile("v_cvt_pk_bf16_f32 %0, %1, %2" : "=v"(r) : "v"(lo), "v"(hi)); return r; }

template <class Epi, class Sched, bool ALIGN_EPI>
__device__ __forceinline__ void gemm_phase(PG8_LAS unsigned char* lds, const Gemm g, const Sched& S, const Epi& E) {
    const int tid = threadIdx.x, wid = __builtin_amdgcn_readfirstlane(tid >> 6), lane = tid & 63, wr = wid >> 2, wc = wid & 3, fr = lane & 15, fq = lane >> 4;
    const int K = g.K, nt = K / BK;
    unsigned voffA[2], voffB[2];
#pragma unroll
    for (int i = 0; i < 2; ++i) { int R, C; stage_rc(tid * 16 + i * 8192, R, C); const int Rb = Epi::PERM ? ((R & ~31) + perm32(R & 31)) : R;
        voffA[i] = (unsigned)(R * g.lda + C) * 2u; voffB[i] = (unsigned)(Rb * g.ldb + C) * 2u; }
    const size_t kstep = (size_t)(BK * 2);
    const size_t hstepA = (size_t)HALF * g.lda * 2, hstepB = (size_t)HALF * g.ldb * 2;
    const size_t tstepA = 2 * hstepA, tstepB = 2 * hstepB;
    const unsigned ldsw = (unsigned)wid * 1024u;
    const int aoff = lds_byte(wr * 64 + fr, fq * 8), boff = lds_byte(wc * 32 + fr, fq * 8);
#define PG8_SA(b, h) (((b) * 2 + (h)) * HTB)
#define PG8_SB(b, h) ((4 + (b) * 2 + (h)) * HTB)
#define PG8_STAGE(bufoff, gbase, voff) do { _Pragma("unroll") for (int _i = 0; _i < 2; ++_i) \
        __builtin_amdgcn_global_load_lds((const unsigned*)((const char*)(gbase) + (voff)[_i]), (PG8_LAS unsigned*)(lds + (bufoff) + ldsw + _i * 8192), 16, 0, 0); } while (0)
#define PG8_LDA(dst, b, h) do { _Pragma("unroll") for (int m = 0; m < 4; ++m) _Pragma("unroll") for (int k = 0; k < 2; ++k) dst[m][k] = *(const PG8_LAS bf16x8*)(lds + PG8_SA(b, h) + aoff + m * 2048 + k * 1024); } while (0)
#define PG8_LDB(dst, b, h) do { _Pragma("unroll") for (int n = 0; n < 2; ++n) _Pragma("unroll") for (int k = 0; k < 2; ++k) dst[n][k] = *(const PG8_LAS bf16x8*)(lds + PG8_SB(b, h) + boff + n * 2048 + k * 1024); } while (0)
#define PG8_MMA(ai, bj, At, Bt) do { __builtin_amdgcn_s_setprio(1); _Pragma("unroll") for (int m = 0; m < 4; ++m) _Pragma("unroll") for (int n = 0; n < 2; ++n) _Pragma("unroll") for (int k = 0; k < 2; ++k) \
        acc[ai][bj][m][n] = __builtin_amdgcn_mfma_f32_16x16x32_bf16(Bt[n][k], At[m][k], acc[ai][bj][m][n], 0, 0, 0); __builtin_amdgcn_s_setprio(0); } while (0)
#define PG8_WAIT_V(n) asm volatile("s_waitcnt vmcnt(" #n ")" ::: "memory")
#define PG8_WAIT_L(n) asm volatile("s_waitcnt lgkmcnt(" #n ")" ::: "memory")
#define PG8_BAR __builtin_amdgcn_s_barrier()
#define PG8_SCHED __builtin_amdgcn_sched_barrier(0)
#define PG8_AOFF(u) ((size_t)(((u).pn >> g.apn_shift) * g.apn_elems) * 2)
    Unit cur, nxt; int ui = 0;
    if (!S.next(0, cur)) return;
    f32x4 acc[2][2][4][2];
#pragma unroll
    for (int a = 0; a < 2; ++a)
#pragma unroll
        for (int b = 0; b < 2; ++b)
#pragma unroll
            for (int m = 0; m < 4; ++m)
#pragma unroll
                for (int n = 0; n < 2; ++n) acc[a][b][m][n] = (f32x4){0.f, 0.f, 0.f, 0.f};
    bf16x8 At[4][2], B0[2][2], B1[2][2];
    const char* cA = (const char*)g.A + (size_t)cur.pm * tstepA + PG8_AOFF(cur); const char* cB = (const char*)g.Bt + (size_t)cur.pn * tstepB;
    PG8_STAGE(PG8_SB(0, 0), cB, voffB); PG8_STAGE(PG8_SB(0, 1), cB + hstepB, voffB); PG8_STAGE(PG8_SA(0, 0), cA, voffA); PG8_STAGE(PG8_SA(0, 1), cA + hstepA, voffA);
    if (wr == 1) PG8_BAR;
    PG8_WAIT_V(2); PG8_BAR;
    PG8_STAGE(PG8_SB(1, 0), cB + kstep, voffB); PG8_STAGE(PG8_SA(1, 0), cA + kstep, voffA); PG8_STAGE(PG8_SB(1, 1), cB + hstepB + kstep, voffB);
    PG8_WAIT_V(6); PG8_BAR;
    for (;;) {
        const bool has_next = S.next(ui + 1, nxt);
        const char* nA = has_next ? (const char*)g.A + (size_t)nxt.pm * tstepA + PG8_AOFF(nxt) : cA; const char* nB = has_next ? (const char*)g.Bt + (size_t)nxt.pn * tstepB : cB;
        for (int t = 0; t < nt; t += 2) {
            const bool last = (t == nt - 2);
            const char* a1 = cA + (size_t)(t + 1) * kstep;
            const char* a2 = last ? nA : cA + (size_t)(t + 2) * kstep; const char* b2 = last ? nB : cB + (size_t)(t + 2) * kstep;
            const char* a3 = a2 + kstep; const char* b3 = b2 + kstep;
            PG8_LDB(B0, 0, 0); PG8_LDB(B1, 0, 1); PG8_SCHED; PG8_LDA(At, 0, 0); PG8_STAGE(PG8_SA(1, 1), a1 + hstepA, voffA);
            PG8_WAIT_V(8); PG8_WAIT_L(0); PG8_BAR; PG8_MMA(0, 0, At, B0); PG8_MMA(0, 1, At, B1); PG8_BAR; PG8_SCHED;
            PG8_LDA(At, 0, 1); PG8_STAGE(PG8_SB(0, 0), b2, voffB); PG8_STAGE(PG8_SB(0, 1), b2 + hstepB, voffB); PG8_STAGE(PG8_SA(0, 0), a2, voffA);
            PG8_WAIT_V(8); PG8_WAIT_L(0); PG8_BAR; PG8_MMA(1, 0, At, B0); PG8_MMA(1, 1, At, B1); PG8_BAR; PG8_SCHED;
            PG8_LDB(B0, 1, 0); PG8_LDB(B1, 1, 1); PG8_SCHED; PG8_LDA(At, 1, 0); PG8_STAGE(PG8_SA(0, 1), a2 + hstepA, voffA);
            PG8_WAIT_V(8); PG8_WAIT_L(0); PG8_BAR; PG8_MMA(0, 0, At, B0); PG8_MMA(0, 1, At, B1); PG8_BAR; PG8_SCHED;
            PG8_LDA(At, 1, 1); PG8_STAGE(PG8_SB(1, 0), b3, voffB); PG8_STAGE(PG8_SB(1, 1), b3 + hstepB, voffB); PG8_STAGE(PG8_SA(1, 0), a3, voffA);
            PG8_WAIT_V(8); PG8_WAIT_L(0); PG8_BAR; PG8_MMA(1, 0, At, B0); PG8_MMA(1, 1, At, B1); PG8_BAR; PG8_SCHED;
        }
        if constexpr (ALIGN_EPI) { if (wr == 0) PG8_BAR; }
        E(acc, cur, wr, wc, fr, fq);
        if (!has_next) break;
#pragma unroll
        for (int a = 0; a < 2; ++a)
#pragma unroll
            for (int b = 0; b < 2; ++b)
#pragma unroll
                for (int m = 0; m < 4; ++m)
#pragma unroll
                    for (int n = 0; n < 2; ++n) acc[a][b][m][n] = (f32x4){0.f, 0.f, 0.f, 0.f};
        cur = nxt; cA = nA; cB = nB; ++ui;
        if constexpr (ALIGN_EPI) { if (wr == 1) PG8_BAR; }
    }
    PG8_WAIT_V(0);
    if constexpr (!ALIGN_EPI) { if (wr == 0) PG8_BAR; }
    PG8_BAR;
#undef PG8_SA
#undef PG8_SB
#undef PG8_STAGE
#undef PG8_LDA
#undef PG8_LDB
#undef PG8_MMA
#undef PG8_WAIT_V
#undef PG8_WAIT_L
#undef PG8_BAR
#undef PG8_SCHED
#undef PG8_AOFF
}
}

#define LAS __attribute__((address_space(3)))
typedef unsigned short bf16_t;
typedef unsigned v4u __attribute__((ext_vector_type(4)));
typedef unsigned v2u __attribute__((ext_vector_type(2)));
typedef float f32x4 __attribute__((ext_vector_type(4)));
typedef short bf16x8 __attribute__((ext_vector_type(8)));

constexpr int D = 1024, TP = 2048, TS = 64, NBP = 16, NBS = 32;
constexpr int MP = NBP * TP;
constexpr int MS = NBS * TS;
constexpr int M = MP + MS;
constexpr float EPS = 1e-6f;
constexpr size_t O_Y = 0, O_CONVP = 35651584, O_HP = 35700736, O_KP = 35717120, O_VP = 35979264, O_CONVS = 36241408, O_HS = 36339712, O_KS = 36372480, O_VS = 36896768;
constexpr size_t MiB = 1u << 20;
constexpr size_t WS_WINA = 1 * MiB, WS_WGATE = 5 * MiB, WS_WOUTA = 6 * MiB, WS_WB = 8 * MiB, WS_WOUTB = 13 * MiB, WS_SS = 15 * MiB, WS_CP = 16 * MiB, WS_CH = 19 * MiB,
                 WS_KC = 22 * MiB, WS_VTC = 23 * MiB, WS_VTS = 24 * MiB, WS_KB = 25 * MiB, WS_VTP = 34 * MiB, WS_R1 = 48 * MiB, WS_R2 = 116 * MiB, WS_R3 = 252 * MiB, WS_END = 388 * MiB;
constexpr int LDS_BYTES = 135168;
constexpr int NPH = 10;

__device__ __forceinline__ unsigned pk2(float lo, float hi) { return pg8::cvt_pk_bf16(lo, hi); }
__device__ __forceinline__ float bflo(unsigned w) { return __uint_as_float(w << 16); }
__device__ __forceinline__ float bfhi(unsigned w) { return __uint_as_float(w & 0xffff0000u); }
__device__ __forceinline__ float bf2f(bf16_t b) { return __uint_as_float((unsigned)b << 16); }
__device__ __forceinline__ float sigmoidf_(float x) { return __builtin_amdgcn_rcpf(1.0f + __expf(-x)); }
__device__ __forceinline__ float wave_sum(float v) {
#pragma unroll
    for (int o = 1; o < 64; o <<= 1) v += __shfl_xor(v, o);
    return v;
}

using pg8::Unit;
struct EpiStore {
    static constexpr bool PERM = true;
    bf16_t* O; int ldc;
    __device__ __forceinline__ void operator()(const f32x4 (&acc)[2][2][4][2], const Unit& u, int wr, int wc, int fr_, int fq_) const {
        int fr = fr_, fq = fq_; asm volatile("" : "+v"(fr), "+v"(fq));
        const int row0 = u.pm * 256 + wr * 64 + fr, col0 = u.pn * 256 + wc * 32 + 8 * fq;
#pragma unroll
        for (int ai = 0; ai < 2; ++ai)
#pragma unroll
            for (int m = 0; m < 4; ++m) { bf16_t* rowp = O + (size_t)(row0 + ai * 128 + m * 16) * ldc + col0;
#pragma unroll
                for (int bj = 0; bj < 2; ++bj) { const f32x4 v0 = acc[ai][bj][m][0], v1 = acc[ai][bj][m][1];
                    v4u w; w.x = pk2(v0[0], v0[1]); w.y = pk2(v0[2], v0[3]); w.z = pk2(v1[0], v1[1]); w.w = pk2(v1[2], v1[3]);
                    *(v4u*)(rowp + bj * 128) = w; } }
    }
};
struct EpiGate {
    static constexpr bool PERM = true;
    const bf16_t* XC; const float* bgx; const float* bga; const float* lam; unsigned* AB;
    __device__ __forceinline__ void operator()(const f32x4 (&acc)[2][2][4][2], const Unit& u, int wr, int wc, int fr_, int fq_) const {
        int fr = fr_, fq = fq_; asm volatile("" : "+v"(fr), "+v"(fq));
        const int row0 = u.pm * 256 + wr * 64 + fr, ch0 = u.pn * 128 + wc * 32 + 8 * fq;
#pragma unroll
        for (int ai = 0; ai < 2; ++ai)
#pragma unroll
            for (int m = 0; m < 4; ++m) { const size_t off = (size_t)(row0 + ai * 128 + m * 16) * D + ch0;
                asm volatile("" ::: "memory");
                const v4u xw = *(const v4u*)(XC + off);
                float xc[8] = {bflo(xw.x), bfhi(xw.x), bflo(xw.y), bfhi(xw.y), bflo(xw.z), bfhi(xw.z), bflo(xw.w), bfhi(xw.w)};
#pragma unroll
                for (int n = 0; n < 2; ++n) { const f32x4 t0 = *(const f32x4*)(bgx + ch0 + 4 * n), t1 = *(const f32x4*)(bga + ch0 + 4 * n), t2 = *(const f32x4*)(lam + ch0 + 4 * n);
                    unsigned ow[4];
#pragma unroll
                    for (int e = 0; e < 4; ++e) {
                        const float ig = sigmoidf_(acc[ai][0][m][n][e] + t0[e]);
                        const float rg = sigmoidf_(acc[ai][1][m][n][e] + t1[e]);
                        const float la = t2[e] * rg;
                        const float a = __expf(la);
                        const float mult = sqrtf(fmaxf(1.0f - a * a, 0.f));
                        const float bxv = mult * ig * xc[4 * n + e];
                        const _Float16 lh = (_Float16)la;
                        ow[e] = (unsigned)__builtin_bit_cast(unsigned short, lh) | (pk2(bxv, bxv) & 0xffff0000u); }
                    *(v4u*)(AB + off + 4 * n) = (v4u){ow[0], ow[1], ow[2], ow[3]};
                    __builtin_amdgcn_sched_barrier(0); } }
    }
};
struct EpiOutA {
    static constexpr bool PERM = true;
    const float* xp; const float* xs; float* X1; bf16_t* X1B; float* SS;
    __device__ __forceinline__ void operator()(const f32x4 (&acc)[2][2][4][2], const Unit& u, int wr, int wc, int fr_, int fq_) const {
        int fr = fr_, fq = fq_; asm volatile("" : "+v"(fr), "+v"(fq));
        const int row0 = u.pm * 256 + wr * 64 + fr, col0 = u.pn * 256 + wc * 32 + 8 * fq;
#pragma unroll
        for (int ai = 0; ai < 2; ++ai)
#pragma unroll
            for (int m = 0; m < 4; ++m) { const int row = row0 + ai * 128 + m * 16;
                asm volatile("" ::: "memory");
                const float* xr = (row < MP) ? xp + (size_t)row * D : xs + (size_t)(row - MP) * D;
                float ssq = 0.f;
#pragma unroll
                for (int bj = 0; bj < 2; ++bj) { const int c = col0 + bj * 128;
                    const f32x4 v0 = acc[ai][bj][m][0] + *(const f32x4*)(xr + c), v1 = acc[ai][bj][m][1] + *(const f32x4*)(xr + c + 4);
                    *(f32x4*)(X1 + (size_t)row * D + c) = v0; *(f32x4*)(X1 + (size_t)row * D + c + 4) = v1;
                    v4u w; w.x = pk2(v0[0], v0[1]); w.y = pk2(v0[2], v0[3]); w.z = pk2(v1[0], v1[1]); w.w = pk2(v1[2], v1[3]);
                    *(v4u*)(X1B + (size_t)row * D + c) = w;
                    ssq += (v0[0] * v0[0] + v0[1] * v0[1]) + (v0[2] * v0[2] + v0[3] * v0[3]) + (v1[0] * v1[0] + v1[1] * v1[1]) + (v1[2] * v1[2] + v1[3] * v1[3]); }
                ssq += __shfl_xor(ssq, 16); ssq += __shfl_xor(ssq, 32);
                if (fq == 0) atomicAdd(SS + row, ssq); }
    }
};
struct EpiB {
    static constexpr bool PERM = true;
    const float* SS; const float* qg; const float* kg; bf16_t* QB; bf16_t* GB; bf16_t* KB; bf16_t* VTP; bf16_t* VTS; float* out;
    __device__ __forceinline__ void operator()(const f32x4 (&acc)[2][2][4][2], const Unit& u, int wr, int wc, int fr_, int fq_) const {
        int fr = fr_, fq = fq_; asm volatile("" : "+v"(fr), "+v"(fq));
        const int Hd = 4 * u.pn + wc, row0 = u.pm * 256 + wr * 64 + fr;
        const bool normed = (Hd < 16) || (Hd == 32) || (Hd == 33);
        const float* gsrc = (Hd < 16) ? qg : kg; const float gscale = (Hd < 16) ? 0.125f : 1.0f;
#pragma unroll
        for (int ai = 0; ai < 2; ++ai)
#pragma unroll
            for (int m = 0; m < 4; ++m) { const int row = row0 + ai * 128 + m * 16;
                asm volatile("" ::: "memory");
                const float rs = rsqrtf(SS[row] * (1.0f / D) + EPS);
                float v[2][8];
#pragma unroll
                for (int bj = 0; bj < 2; ++bj)
#pragma unroll
                    for (int n = 0; n < 2; ++n)
#pragma unroll
                        for (int e = 0; e < 4; ++e) v[bj][4 * n + e] = acc[ai][bj][m][n][e] * rs;
                if (normed) {
                    float ssq = 0.f;
#pragma unroll
                    for (int bj = 0; bj < 2; ++bj)
#pragma unroll
                        for (int e = 0; e < 8; ++e) ssq += v[bj][e] * v[bj][e];
                    ssq += __shfl_xor(ssq, 16); ssq += __shfl_xor(ssq, 32);
                    const float hn = rsqrtf(ssq * (1.0f / 64.0f) + EPS) * gscale;
#pragma unroll
                    for (int bj = 0; bj < 2; ++bj) { const f32x4 g0 = *(const f32x4*)(gsrc + 32 * bj + 8 * fq), g1 = *(const f32x4*)(gsrc + 32 * bj + 8 * fq + 4);
#pragma unroll
                        for (int e = 0; e < 4; ++e) { v[bj][e] *= hn * g0[e]; v[bj][4 + e] *= hn * g1[e]; } }
                }
                if (Hd < 32) {
                    if (Hd >= 16) {
#pragma unroll
                        for (int bj = 0; bj < 2; ++bj)
#pragma unroll
                            for (int e = 0; e < 8; ++e) v[bj][e] = v[bj][e] * sigmoidf_(v[bj][e]);
                    }
                    bf16_t* dst = ((Hd < 16) ? QB : GB) + (size_t)row * D + (Hd & 15) * 64 + 8 * fq;
#pragma unroll
                    for (int bj = 0; bj < 2; ++bj) { v4u w; w.x = pk2(v[bj][0], v[bj][1]); w.y = pk2(v[bj][2], v[bj][3]); w.z = pk2(v[bj][4], v[bj][5]); w.w = pk2(v[bj][6], v[bj][7]);
                        *(v4u*)(dst + 32 * bj) = w; }
                } else {
                    const int h = Hd & 1; const bool isv = Hd >= 34;
                    float* od = nullptr; int sq, t;
                    if (row < MP) { sq = row >> 11; t = row & 2047; if (t >= TP - 128) od = out + (isv ? O_VP : O_KP) + ((size_t)(sq * 128 + (t - (TP - 128))) * 2 + h) * 64; }
                    else { sq = (row - MP) >> 6; t = (row - MP) & 63; od = out + (isv ? O_VS : O_KS) + ((size_t)(sq * 128 + 64 + t) * 2 + h) * 64; }
                    if (od) {
#pragma unroll
                        for (int bj = 0; bj < 2; ++bj) { float* p = od + 32 * bj + 8 * fq;
                            *(f32x4*)p = (f32x4){v[bj][0], v[bj][1], v[bj][2], v[bj][3]}; *(f32x4*)(p + 4) = (f32x4){v[bj][4], v[bj][5], v[bj][6], v[bj][7]}; }
                    }
                    if (!isv) {
                        bf16_t* dst = KB + (size_t)row * 128 + h * 64 + 8 * fq;
#pragma unroll
                        for (int bj = 0; bj < 2; ++bj) { v4u w; w.x = pk2(v[bj][0], v[bj][1]); w.y = pk2(v[bj][2], v[bj][3]); w.z = pk2(v[bj][4], v[bj][5]); w.w = pk2(v[bj][6], v[bj][7]);
                            *(v4u*)(dst + 32 * bj) = w; }
                    } else {
                        bf16_t* vb; int pitch;
                        if (row < MP) { vb = VTP + (size_t)((sq * 2 + h) * 64) * TP + t; pitch = TP; } else { vb = VTS + (size_t)((sq * 2 + h) * 64) * TS + t; pitch = TS; }
#pragma unroll
                        for (int bj = 0; bj < 2; ++bj)
#pragma unroll
                            for (int e = 0; e < 8; ++e) vb[(size_t)(32 * bj + 8 * fq + e) * pitch] = (bf16_t)(pk2(v[bj][e], v[bj][e]) & 0xffffu);
                    }
                }
            }
    }
};
struct EpiOutB {
    static constexpr bool PERM = true;
    float* Y;
    __device__ __forceinline__ void operator()(const f32x4 (&acc)[2][2][4][2], const Unit& u, int wr, int wc, int fr_, int fq_) const {
        int fr = fr_, fq = fq_; asm volatile("" : "+v"(fr), "+v"(fq));
        const int row0 = u.pm * 256 + wr * 64 + fr, col0 = u.pn * 256 + wc * 32 + 8 * fq;
#pragma unroll
        for (int ai = 0; ai < 2; ++ai)
#pragma unroll
            for (int m = 0; m < 4; ++m) { float* yr = Y + (size_t)(row0 + ai * 128 + m * 16) * D + col0;
                asm volatile("" ::: "memory");
#pragma unroll
                for (int bj = 0; bj < 2; ++bj) { float* p = yr + bj * 128;
                    const f32x4 v0 = acc[ai][bj][m][0] + *(const f32x4*)p, v1 = acc[ai][bj][m][1] + *(const f32x4*)(p + 4);
                    *(f32x4*)p = v0; *(f32x4*)(p + 4) = v1; } }
    }
};

struct RmId { __device__ __forceinline__ int operator()(int n) const { return n; } };
struct RmGate { int g, isA; __device__ __forceinline__ int operator()(int n) const { return 256 * (2 * g + (n >> 7)) + (n & 127) + (isA ? 128 : 0); } };
struct RmHead { int head0; __device__ __forceinline__ int operator()(int n) const { const int H = head0 + (n >> 6), j = n & 63; return 256 * (H >> 2) + 128 * (j >> 5) + 32 * (H & 3) + (j & 31); } };
template <class RM>
__device__ __forceinline__ void transpose_item(const float* W, int ldw, int nblk, const float* gain, bf16_t* WT, int ldt, const RM rm, LAS float* scr, int item, int lane) {
    const int kb = item / nblk, nb = item % nblk, k0 = 64 * kb, n0 = 32 * nb;
#pragma unroll 8
    for (int i = 0; i < 32; ++i) { const int kk = 2 * i + (lane >> 5); const float gsc = gain ? gain[k0 + kk] : 1.0f; scr[kk * 33 + (lane & 31)] = W[(size_t)(k0 + kk) * ldw + n0 + (lane & 31)] * gsc; }
    asm volatile("s_waitcnt lgkmcnt(0)" ::: "memory");
    const int c = lane & 7;
#pragma unroll
    for (int j = 0; j < 4; ++j) { const int n = (lane >> 3) + 8 * j; const LAS float* s = scr + (8 * c) * 33 + n;
        v4u o; o.x = pk2(s[0 * 33], s[1 * 33]); o.y = pk2(s[2 * 33], s[3 * 33]); o.z = pk2(s[4 * 33], s[5 * 33]); o.w = pk2(s[6 * 33], s[7 * 33]);
        *(v4u*)(WT + (size_t)rm(n0 + n) * ldt + k0 + 8 * c) = o; }
    asm volatile("s_waitcnt lgkmcnt(0)" ::: "memory");
}


#define XB_TMO      128
#define XB_XCNT(j)  (256  + 64 * (j))
#define XB_XSUB(j)  (1280 + 64 * (j))
#define XB_XGEN(j)  (2304 + 64 * (j))
#define XB_TOP      3328
#define XB_TOPGEN   3392
#define XCD_BAR_WORDS 3456
#define XB_SPIN_CAP (1u << 22)
__device__ __forceinline__ unsigned xb_ld(unsigned* p)              { return __hip_atomic_load(p, __ATOMIC_RELAXED, __HIP_MEMORY_SCOPE_AGENT); }
__device__ __forceinline__ unsigned xb_add(unsigned* p, unsigned v) { return __hip_atomic_fetch_add(p, v, __ATOMIC_RELAXED, __HIP_MEMORY_SCOPE_AGENT); }
__device__ __forceinline__ unsigned xb_xcc_id() { return (unsigned)__builtin_amdgcn_s_getreg((3 << 11) | 20) & 0xFu; }
#define XB_SPIN(cond, bar) do { unsigned _sp = 0; while (cond) { __builtin_amdgcn_s_sleep(1); \
    if ((++_sp & 255u) == 0u) { if (xb_ld(&(bar)[XB_TMO])) break; if (_sp > XB_SPIN_CAP) { atomicAdd(&(bar)[XB_TMO], 1u); break; } } } } while (0)
struct XcdBarrier { unsigned* bar; unsigned x; volatile LAS unsigned* st; };
__device__ __forceinline__ XcdBarrier xcd_barrier_post(unsigned* bar, volatile LAS unsigned* st) {
    XcdBarrier b; b.bar = bar; b.x = xb_xcc_id(); b.st = st;
    if (threadIdx.x == 0) (void)xb_add(&bar[XB_XCNT(b.x)], 1u);
    return b;
}
__device__ __forceinline__ void xcd_barrier_complete(unsigned* bar, unsigned x, unsigned& nloc, unsigned& nx) {
    const unsigned G = gridDim.x * gridDim.y * gridDim.z;
    unsigned sum, cnt, mine, sp = 0u;
    for (;;) {
        sum = 0u; cnt = 0u; mine = 0u;
#pragma unroll
        for (unsigned j = 0; j < 16; ++j) { const unsigned c = xb_ld(&bar[XB_XCNT(j)]); sum += c; cnt += (c > 0u) ? 1u : 0u; mine = (j == x) ? c : mine; }
        if (sum == G) break;
        __builtin_amdgcn_s_sleep(1);
        if ((++sp & 255u) == 0u) { if (xb_ld(&bar[XB_TMO])) break; if (sp > XB_SPIN_CAP) { atomicAdd(&bar[XB_TMO], 1u); break; } }
    }
    nloc = mine > 0u ? mine : 1u; nx = cnt > 0u ? cnt : 1u;
}
__device__ __forceinline__ void xcd_barrier(const XcdBarrier& b) {
    asm volatile("s_waitcnt vmcnt(0)" ::: "memory");
    __syncthreads();
    if (threadIdx.x == 0) {
        unsigned* bar = b.bar;
        __builtin_amdgcn_s_waitcnt(0);
        unsigned nloc = b.st[0], nx = b.st[1];
        if (nloc == 0u) { xcd_barrier_complete(bar, b.x, nloc, nx); b.st[0] = nloc; b.st[1] = nx; }
        const unsigned old = xb_add(&bar[XB_XSUB(b.x)], 1u);
        const unsigned gen = old / nloc;
        if (old + 1u == (gen + 1u) * nloc) {
            __builtin_amdgcn_fence(__ATOMIC_RELEASE, "agent");
            asm volatile("s_waitcnt vmcnt(0)" ::: "memory");
            const unsigned og = xb_add(&bar[XB_TOP], 1u);
            const unsigned tg = og / nx;
            if (og + 1u == (tg + 1u) * nx) xb_add(&bar[XB_TOPGEN], 1u);
            else XB_SPIN(xb_ld(&bar[XB_TOPGEN]) == tg, bar);
            __builtin_amdgcn_fence(__ATOMIC_ACQUIRE, "agent");
            xb_add(&bar[XB_XGEN(b.x)], 1u);
            asm volatile("s_waitcnt vmcnt(0)" ::: "memory");
        } else {
            XB_SPIN(xb_ld(&bar[XB_XGEN(b.x)]) == gen, bar);
            __builtin_amdgcn_fence(__ATOMIC_ACQUIRE, "agent");
            asm volatile("s_waitcnt vmcnt(0)" ::: "memory");
        }
    }
    __syncthreads();
}

struct Args { const float* in[24]; float* out; unsigned char* ws; int ph_lo, ph_hi; };

__global__ void __launch_bounds__(512, 2) yoco_fwd(Args args) {
    extern __shared__ __attribute__((aligned(16))) unsigned char lds_raw[];
    LAS unsigned char* lds = (LAS unsigned char*)lds_raw;
    const int tid = threadIdx.x, lane = tid & 63, wave = __builtin_amdgcn_readfirstlane(tid >> 6);
    const int G = gridDim.x, bid = blockIdx.x;
    const int gw = bid * 8 + wave, NGW = G * 8;
    const int gtid = bid * 512 + tid, NT = G * 512;
    unsigned char* ws = args.ws; float* out = args.out;
typedef const float* cfp_t;
#define ARGP(k) (((cfp_t const volatile __attribute__((address_space(4)))*)__builtin_amdgcn_kernarg_segment_ptr())[k])
    bf16_t* WT_INA = (bf16_t*)(ws + WS_WINA); bf16_t* WT_GATE = (bf16_t*)(ws + WS_WGATE); bf16_t* WT_OUTA = (bf16_t*)(ws + WS_WOUTA);
    bf16_t* WT_B = (bf16_t*)(ws + WS_WB); bf16_t* WT_OUTB = (bf16_t*)(ws + WS_WOUTB);
    float* SS = (float*)(ws + WS_SS); float* CL = (float*)(ws + WS_SS + 512 * 1024); float* CP = (float*)(ws + WS_CP); float* CH = (float*)(ws + WS_CH);
    bf16_t* KC = (bf16_t*)(ws + WS_KC); bf16_t* VTC = (bf16_t*)(ws + WS_VTC); bf16_t* VTS = (bf16_t*)(ws + WS_VTS);
    bf16_t* KB = (bf16_t*)(ws + WS_KB); bf16_t* VTP = (bf16_t*)(ws + WS_VTP);
    bf16_t* XN = (bf16_t*)(ws + WS_R1); bf16_t* XC = XN; bf16_t* HG = XN;
    bf16_t* U = (bf16_t*)(ws + WS_R2); bf16_t* X1B = U;
    unsigned* AB = (unsigned*)(ws + WS_R3); bf16_t* QB = (bf16_t*)(ws + WS_R3); bf16_t* GB = QB + (size_t)M * D;
    const int lo = args.ph_lo, hi = args.ph_hi;
#ifdef ONLYPH
#define IN(k) ((k) == ONLYPH && lo <= (k) && (k) < hi)
#else
#define IN(k) (lo <= (k) && (k) < hi)
#endif
#if MK_SINGLE
    volatile LAS unsigned* MISC = (volatile LAS unsigned*)(lds + 131072);
    if (tid < 64) MISC[tid] = 0u;
    __syncthreads();
    const XcdBarrier bar = xcd_barrier_post((unsigned*)ws, MISC + 8);
    cg::this_grid().sync();
#define SEAM(k) do { if (IN(k) && IN((k) + 1)) xcd_barrier(bar); } while (0)
#else
#define SEAM(k) do { } while (0)
#endif

    if (IN(0)) {
        const float* xp = ARGP(0); const float* xs = ARGP(1); const float* cache_k = ARGP(4); const float* cache_v = ARGP(5); const float* norm_a = ARGP(6); const float* w_in_a = ARGP(7);
        const float* w_gx = ARGP(10); const float* w_ga = ARGP(12); const float* lam = ARGP(14); const float* w_out_a = ARGP(15); const float* norm_kv = ARGP(16); const float* w_kv = ARGP(17);
        const float* norm_b = ARGP(19); const float* w_in_b = ARGP(20); const float* w_out_b = ARGP(23);
        LAS float* scr = (LAS float*)(lds + wave * 16384);
        constexpr int NITEMS = 1024 + 256 + 512 + 1024 + 128 + 512;
        for (int it = gw; it < NITEMS; it += NGW) {
            int r = it;
            if (r < 1024) { transpose_item(w_in_a, 2048, 64, norm_a, WT_INA, 1024, RmId{}, scr, r, lane); continue; } r -= 1024;
            if (r < 256) { const int gm = r >> 5, gi = gm & 3, isA = gm >> 2; transpose_item((isA ? w_ga : w_gx) + (size_t)gi * 65536, 256, 8, nullptr, WT_GATE, 256, RmGate{gi, isA}, scr, r & 31, lane); continue; } r -= 256;
            if (r < 512) { transpose_item(w_out_a, 1024, 32, nullptr, WT_OUTA, 1024, RmId{}, scr, r, lane); continue; } r -= 512;
            if (r < 1024) { transpose_item(w_in_b, 2048, 64, norm_b, WT_B, 1024, RmHead{0}, scr, r, lane); continue; } r -= 1024;
            if (r < 128) { transpose_item(w_kv, 256, 8, norm_kv, WT_B, 1024, RmHead{32}, scr, r, lane); continue; } r -= 128;
            transpose_item(w_out_b, 1024, 32, nullptr, WT_OUTB, 1024, RmId{}, scr, r, lane);
        }
        for (int m = gw; m < M; m += NGW) {
            const float* xrow = (m < MP) ? xp + (size_t)m * D : xs + (size_t)(m - MP) * D;
            const f32x4* xr = (const f32x4*)xrow + lane;
            f32x4 v[4]; float s = 0.f;
#pragma unroll
            for (int j = 0; j < 4; ++j) { v[j] = xr[64 * j]; s += (v[j].x * v[j].x + v[j].y * v[j].y) + (v[j].z * v[j].z + v[j].w * v[j].w); }
            const float rs = rsqrtf(wave_sum(s) * (1.0f / D) + EPS);
            v2u* o8 = (v2u*)(XN + (size_t)m * D) + lane;
#pragma unroll
            for (int j = 0; j < 4; ++j) o8[64 * j] = (v2u){pk2(v[j].x * rs, v[j].y * rs), pk2(v[j].z * rs, v[j].w * rs)};
        }
        for (int i = gtid; i < M; i += NT) SS[i] = 0.f;
        for (int i = gtid; i < D; i += NT) { const float l = lam[i]; CL[i] = 8.0f * (fminf(l, 0.f) - log1pf(__expf(-fabsf(l)))); }
        for (int i = gtid; i < NBS * 128 * 128; i += NT) { KC[i] = (bf16_t)(pk2(cache_k[i], 0.f) & 0xffffu);
            const int t = i & 127, d = (i >> 7) & 63, h = (i >> 13) & 1, b = i >> 14;
            VTC[i] = (bf16_t)(pk2(cache_v[((size_t)(b * 128 + t) * 2 + h) * 64 + d], 0.f) & 0xffffu); }
        for (int i = gtid; i < NBS * 64 * 128; i += NT) { const int b = i >> 13, rem = i & 8191;
            out[O_KS + (size_t)b * 16384 + rem] = cache_k[(size_t)b * 16384 + 8192 + rem];
            out[O_VS + (size_t)b * 16384 + rem] = cache_v[(size_t)b * 16384 + 8192 + rem]; }
        __syncthreads();
    }
    SEAM(0);

    if (IN(1)) {
        pg8::Gemm g{XN, WT_INA, M, 2048, 1024, 1024, 1024, 0, 0}; pg8::StaticOrder S; S.init(M, 2048, G, bid);
        EpiStore E{U, 2048};
        pg8::gemm_phase<EpiStore, pg8::StaticOrder, true>(lds, g, S, E);
    }
    SEAM(1);

    if (IN(2)) {
        const float* state_conv = ARGP(2); const float* conv_w = ARGP(8); const float* conv_b = ARGP(9);
        for (int it = gw; it < (M / 16) * 2; it += NGW) {
            const int row0 = (it >> 1) * 16, c0 = (it & 1) * 512 + lane * 8;
            int t0, T; const float* st = nullptr; float* cso;
            if (row0 < MP) { t0 = row0 & 2047; T = TP; cso = out + O_CONVP + (size_t)(row0 >> 11) * 3 * D; }
            else { const int r = row0 - MP; t0 = r & 63; T = TS; st = state_conv + (size_t)(r >> 6) * 3 * D; cso = out + O_CONVS + (size_t)(r >> 6) * 3 * D; }
            float w[4][8], bb[8], xh[3][8];
#pragma unroll
            for (int e = 0; e < 8; ++e) { bb[e] = conv_b[c0 + e];
#pragma unroll
                for (int j = 0; j < 4; ++j) w[j][e] = conv_w[j * D + c0 + e]; }
#pragma unroll
            for (int j = 0; j < 3; ++j) {
                if (t0 == 0) {
#pragma unroll
                    for (int e = 0; e < 8; ++e) xh[j][e] = st ? st[j * D + c0 + e] : 0.f;
                } else {
                    const v4u q = *(const v4u*)(U + (size_t)(row0 - 3 + j) * 2048 + c0);
                    xh[j][0] = bflo(q.x); xh[j][1] = bfhi(q.x); xh[j][2] = bflo(q.y); xh[j][3] = bfhi(q.y); xh[j][4] = bflo(q.z); xh[j][5] = bfhi(q.z); xh[j][6] = bflo(q.w); xh[j][7] = bfhi(q.w);
                }
            }
#pragma unroll
            for (int r = 0; r < 16; ++r) {
                const v4u q = *(const v4u*)(U + (size_t)(row0 + r) * 2048 + c0);
                float x3[8] = {bflo(q.x), bfhi(q.x), bflo(q.y), bfhi(q.y), bflo(q.z), bfhi(q.z), bflo(q.w), bfhi(q.w)};
                float o[8];
#pragma unroll
                for (int e = 0; e < 8; ++e) o[e] = bb[e] + w[0][e] * xh[0][e] + w[1][e] * xh[1][e] + w[2][e] * xh[2][e] + w[3][e] * x3[e];
                *(v4u*)(XC + (size_t)(row0 + r) * D + c0) = (v4u){pk2(o[0], o[1]), pk2(o[2], o[3]), pk2(o[4], o[5]), pk2(o[6], o[7])};
                if (t0 + r >= T - 3) { float* p = cso + (size_t)(t0 + r - (T - 3)) * D + c0;
                    *(f32x4*)p = (f32x4){x3[0], x3[1], x3[2], x3[3]}; *(f32x4*)(p + 4) = (f32x4){x3[4], x3[5], x3[6], x3[7]}; }
#pragma unroll
                for (int e = 0; e < 8; ++e) { xh[0][e] = xh[1][e]; xh[1][e] = xh[2][e]; xh[2][e] = x3[e]; }
            }
        }
        __syncthreads();
    }
    SEAM(2);

    if (IN(3)) {
        pg8::Gemm g{XC, WT_GATE, M, 2048, 256, 1024, 256, 1, 256}; pg8::StaticOrder S; S.init(M, 2048, G, bid);
        EpiGate E{XC, ARGP(11), ARGP(13), CL, AB};
        pg8::gemm_phase<EpiGate, pg8::StaticOrder, true>(lds, g, S, E);
    }
    SEAM(3);

    if (IN(4)) {
        for (int it = gw; it < (M / 64) * 16; it += NGW) {
            const int uid = it >> 4, c = (it & 15) * 64 + lane;
            const unsigned* p = AB + (size_t)uid * 64 * D + c;
            float P = 1.f, H = 0.f;
#pragma unroll 1
            for (int r0 = 0; r0 < 64; r0 += 16) {
                unsigned wv[16];
#pragma unroll
                for (int i = 0; i < 16; ++i) wv[i] = p[(size_t)(r0 + i) * D];
#pragma unroll
                for (int i = 0; i < 16; ++i) { const float la = (float)__builtin_bit_cast(_Float16, (unsigned short)(wv[i] & 0xffffu)); const float a = __expf(la);
                    P *= a; H = a * H + bfhi(wv[i]); }
            }
            CP[(size_t)uid * D + c] = P; CH[(size_t)uid * D + c] = H;
        }
        __syncthreads();
    }
    SEAM(4);

    if (IN(5)) {
        const float* state_h = ARGP(3);
        for (int it = gw; it < (M / 64) * 16; it += NGW) {
            const int uid = it >> 4, c = (it & 15) * 64 + lane;
            int k; float h;
            if (uid < 512) { k = uid & 31; h = 0.f; } else { k = 0; h = state_h[(size_t)(uid - 512) * D + c]; }
            for (int j = 0; j < k; ++j) { const size_t o = (size_t)(uid - k + j) * D + c; h = CP[o] * h + CH[o]; }
            const unsigned* p = AB + (size_t)uid * 64 * D + c;
            const bf16_t* gp = U + (size_t)uid * 64 * 2048 + 1024 + c;
            bf16_t* hp = HG + (size_t)uid * 64 * D + c;
#pragma unroll 1
            for (int r0 = 0; r0 < 64; r0 += 16) {
                unsigned wv[16]; bf16_t gv[16];
#pragma unroll
                for (int i = 0; i < 16; ++i) { wv[i] = p[(size_t)(r0 + i) * D]; gv[i] = gp[(size_t)(r0 + i) * 2048]; }
#pragma unroll
                for (int i = 0; i < 16; ++i) { const float la = (float)__builtin_bit_cast(_Float16, (unsigned short)(wv[i] & 0xffffu)); const float a = __expf(la);
                    h = a * h + bfhi(wv[i]); const float gt = bf2f(gv[i]); const float hg = h * gt * sigmoidf_(gt);
                    hp[(size_t)(r0 + i) * D] = (bf16_t)(pk2(hg, hg) & 0xffffu); }
            }
            if (uid >= 512) out[O_HS + (size_t)(uid - 512) * D + c] = h;
            else if (k == 31) out[O_HP + (size_t)(uid >> 5) * D + c] = h;
        }
        __syncthreads();
    }
    SEAM(5);

    if (IN(6)) {
        pg8::Gemm g{HG, WT_OUTA, M, 1024, 1024, 1024, 1024, 0, 0}; pg8::StaticOrder S; S.init(M, 1024, G, bid);
        EpiOutA E{ARGP(0), ARGP(1), out + O_Y, X1B, SS};
        pg8::gemm_phase<EpiOutA, pg8::StaticOrder, true>(lds, g, S, E);
    }
    SEAM(6);

    if (IN(7)) {
        pg8::Gemm g{X1B, WT_B, M, 2304, 1024, 1024, 1024, 0, 0}; pg8::StaticOrder S; S.init(M, 2304, G, bid);
        EpiB E{SS, ARGP(21), ARGP(18), QB, GB, KB, VTP, VTS, out};
        pg8::gemm_phase<EpiB, pg8::StaticOrder, true>(lds, g, S, E);
    }
    SEAM(7);

    if (IN(8)) {
        const float* sinks = ARGP(22);
        const int i16 = lane & 15, g4 = lane >> 4;
        for (int u = bid; u < 1088; u += G) {
            int row0, kvh; const bf16_t* kp[3]; const bf16_t* vp[3]; int vpitch[3]; bool valid[3];
            if (u < 1024) { const int s = u >> 6, c = (u >> 1) & 31; kvh = u & 1; row0 = s * TP + 64 * c;
#pragma unroll
                for (int jb = 0; jb < 3; ++jb) { const int cc = c - 2 + jb; valid[jb] = cc >= 0; const int ccc = cc < 0 ? 0 : cc;
                    kp[jb] = KB + (size_t)(s * TP + 64 * ccc) * 128 + kvh * 64; vp[jb] = VTP + (size_t)((s * 2 + kvh) * 64) * TP + 64 * ccc; vpitch[jb] = TP; }
            } else { const int u2 = u - 1024, b = u2 >> 1; kvh = u2 & 1; row0 = MP + 64 * b;
#pragma unroll
                for (int jb = 0; jb < 2; ++jb) { valid[jb] = true; kp[jb] = KC + (size_t)(b * 128 + 64 * jb) * 128 + kvh * 64; vp[jb] = VTC + (size_t)((b * 2 + kvh) * 64) * 128 + 64 * jb; vpitch[jb] = 128; }
                valid[2] = true; kp[2] = KB + (size_t)(MP + 64 * b) * 128 + kvh * 64; vp[2] = VTS + (size_t)((b * 2 + kvh) * 64) * TS; vpitch[2] = TS;
            }
            const int qh = kvh * 8 + wave; const float sk = sinks[qh];
#pragma unroll 1
            for (int qt = 0; qt < 4; ++qt) {
                const size_t qoff = (size_t)(row0 + 16 * qt + i16) * D + qh * 64;
                const bf16x8 qf0 = *(const bf16x8*)(QB + qoff + 8 * g4), qf1 = *(const bf16x8*)(QB + qoff + 32 + 8 * g4);
                f32x4 s[12];
#pragma unroll
                for (int jb = 0; jb < 3; ++jb) {
                    if (valid[jb]) {
#pragma unroll
                        for (int q2 = 0; q2 < 4; ++q2) { const int sb = q2 >> 1, par = q2 & 1;
                            const int kk = 32 * sb + 8 * (i16 >> 2) + (i16 & 3) + 4 * par;
                            const bf16_t* kptr = kp[jb] + (size_t)kk * 128 + 8 * g4;
                            const bf16x8 a0 = *(const bf16x8*)kptr, a1 = *(const bf16x8*)(kptr + 32);
                            f32x4 ac = (f32x4){0.f, 0.f, 0.f, 0.f};
                            ac = __builtin_amdgcn_mfma_f32_16x16x32_bf16(a0, qf0, ac, 0, 0, 0);
                            ac = __builtin_amdgcn_mfma_f32_16x16x32_bf16(a1, qf1, ac, 0, 0, 0);
                            s[4 * jb + q2] = ac; }
                    } else {
#pragma unroll
                        for (int q2 = 0; q2 < 4; ++q2) s[4 * jb + q2] = (f32x4){-1e30f, -1e30f, -1e30f, -1e30f};
                    }
                }
                float mx = sk;
#pragma unroll
                for (int kt = 0; kt < 12; ++kt) mx = fmaxf(fmaxf(mx, fmaxf(s[kt][0], s[kt][1])), fmaxf(s[kt][2], s[kt][3]));
                mx = fmaxf(mx, __shfl_xor(mx, 16)); mx = fmaxf(mx, __shfl_xor(mx, 32));
                float sum = 0.f;
#pragma unroll
                for (int kt = 0; kt < 12; ++kt) {
#pragma unroll
                    for (int r = 0; r < 4; ++r) { const float pv = __expf(s[kt][r] - mx); s[kt][r] = pv; sum += pv; } }
                sum += __shfl_xor(sum, 16); sum += __shfl_xor(sum, 32);
                const float inv = 1.0f / (sum + __expf(sk - mx));
                bf16x8 pf[6];
#pragma unroll
                for (int kb = 0; kb < 6; ++kb) { const f32x4 p0 = s[2 * kb] * inv, p1 = s[2 * kb + 1] * inv;
                    const v4u w = (v4u){pk2(p0[0], p0[1]), pk2(p0[2], p0[3]), pk2(p1[0], p1[1]), pk2(p1[2], p1[3])};
                    pf[kb] = __builtin_bit_cast(bf16x8, w); }
                const size_t ooff = (size_t)(row0 + 16 * qt + i16) * D + qh * 64 + 4 * g4;
#pragma unroll
                for (int dt = 0; dt < 4; ++dt) {
                    f32x4 oc = (f32x4){0.f, 0.f, 0.f, 0.f};
#pragma unroll
                    for (int jb = 0; jb < 3; ++jb) {
                        if (valid[jb]) {
#pragma unroll
                            for (int sb = 0; sb < 2; ++sb) {
                                const bf16x8 vf = *(const bf16x8*)(vp[jb] + (size_t)(16 * dt + i16) * vpitch[jb] + 32 * sb + 8 * g4);
                                oc = __builtin_amdgcn_mfma_f32_16x16x32_bf16(vf, pf[2 * jb + sb], oc, 0, 0, 0); }
                        }
                    }
                    const v2u gw2 = *(const v2u*)(GB + ooff + 16 * dt);
                    *(v2u*)(HG + ooff + 16 * dt) = (v2u){pk2(oc[0] * bflo(gw2.x), oc[1] * bfhi(gw2.x)), pk2(oc[2] * bflo(gw2.y), oc[3] * bfhi(gw2.y))};
                }
            }
        }
        __syncthreads();
    }
    SEAM(8);

    if (IN(9)) {
        pg8::Gemm g{HG, WT_OUTB, M, 1024, 1024, 1024, 1024, 0, 0}; pg8::StaticOrder S; S.init(M, 1024, G, bid);
        EpiOutB E{out + O_Y};
        pg8::gemm_phase<EpiOutB, pg8::StaticOrder, true>(lds, g, S, E);
    }
#undef IN
#undef SEAM
}

extern "C" void kernel_launch(void* const* d_in, const int* in_sizes, int n_in, void* d_out, int out_size, void* d_ws, size_t ws_size, hipStream_t stream) {
    static int grid = 0;
    if (grid == 0) {
        if (n_in != 24 || ws_size < WS_END) { fprintf(stderr, "kernel_launch: unexpected n_in %d / ws %zu\n", n_in, ws_size); grid = -1; return; }
        int dev = 0, cus = 0, per_cu = 0;
        (void)hipGetDevice(&dev);
        (void)hipDeviceGetAttribute(&cus, hipDeviceAttributeMultiprocessorCount, dev);
        if (hipFuncSetAttribute((const void*)yoco_fwd, hipFuncAttributeMaxDynamicSharedMemorySize, LDS_BYTES) != hipSuccess) { fprintf(stderr, "kernel_launch: hipFuncSetAttribute failed\n"); }
        if (hipOccupancyMaxActiveBlocksPerMultiprocessor(&per_cu, (const void*)yoco_fwd, 512, LDS_BYTES) != hipSuccess || per_cu < 1) { fprintf(stderr, "kernel_launch: occupancy query gave %d\n", per_cu); per_cu = 1; }
        (void)hipGetLastError();
        if (per_cu > 1) per_cu = 1;
        grid = cus * per_cu;
    }
    if (grid < 0) return;
    Args a{};
    for (int i = 0; i < 24; ++i) a.in[i] = (const float*)d_in[i];
    a.out = (float*)d_out; a.ws = (unsigned char*)d_ws;
#if MK_SINGLE
    if (hipMemsetAsync(d_ws, 0, 16384, stream) != hipSuccess) { fprintf(stderr, "kernel_launch: memset of the barrier words failed\n"); return; }
    a.ph_lo = 0; a.ph_hi = NPH;
    void* kargs[] = {&a};
    hipError_t e = hipLaunchCooperativeKernel((const void*)yoco_fwd, dim3(grid), dim3(512), kargs, LDS_BYTES, stream);
    if (e != hipSuccess) fprintf(stderr, "cooperative launch failed: %s (grid %d)\n", hipGetErrorString(e), grid);
#else
    for (int ph = 0; ph < NPH; ++ph) {
        a.ph_lo = ph; a.ph_hi = ph + 1;
        hipLaunchKernelGGL(yoco_fwd, dim3(grid), dim3(512), LDS_BYTES, stream, a);
    }
#endif
}
```

```cpp
#include <hip/hip_runtime.h>
#include <hip/hip_cooperative_groups.h>
#include <cstdio>
#include <cstdint>
namespace cg = cooperative_groups;

#ifndef MK_SINGLE
#define MK_SINGLE 1
#endif
#ifndef PROBE_MASK
#define PROBE_MASK 0
#endif
#define REPS(k) (((PROBE_MASK >> (k)) & 1) ? 3 : 1)

namespace pg8 {
#define PG8_LAS __attribute__((address_space(3)))
typedef unsigned short bf16_t;
typedef short bf16x8 __attribute__((ext_vector_type(8)));
typedef float f32x4 __attribute__((ext_vector_type(4)));
typedef unsigned u32x4 __attribute__((ext_vector_type(4)));
constexpr int BM = 256, BK = 64, HALF = 128, HTB = HALF * BK * 2  , STAGE_BYTES = 8 * HTB, NXCD = 8, WGM = 8;

__host__ __device__ __forceinline__ int lds_byte(int r, int c) { const int st = (r >> 4) * 2 + (c >> 5), rr = r & 15, cc = c & 31, ob = rr * 64 + cc * 2; return st * 1024 + (ob ^ (((ob >> 9) & 1) << 5)); }
__host__ __device__ __forceinline__ void stage_rc(int b, int& R, int& C) { const int st = b / 1024, sb = b % 1024, swz = sb ^ (((sb >> 9) & 1) << 5); R = (st >> 1) * 16 + swz / 64; C = (st & 1) * 32 + (swz % 64) / 2; }
__host__ __device__ __forceinline__ int perm32(int rho) { const int n = rho >> 4, i = rho & 15; return 8 * (i >> 2) + 4 * n + (i & 3); }

struct Unit { int pm, pn; };
struct Gemm { const bf16_t* A; const bf16_t* Bt; int M, N, K, lda, ldb, apn_shift, apn_elems; };

struct StaticOrder {
    int nM, nN, nwg, G, c;
    __host__ __device__ void init(int M, int N, int G_, int c_) { nM = M / BM; nN = N / BM; nwg = nM * nN; G = G_; c = c_; }
    __host__ __device__ bool next(int i, Unit& u) const {
        const long L = (long)i * G + c; if (L >= nwg) return false;
        int wgid = (int)L; { const int q = nwg / NXCD, r = nwg % NXCD, xcd = wgid % NXCD, off = wgid / NXCD; wgid = (xcd < r ? xcd * (q + 1) : r * (q + 1) + (xcd - r) * q) + off; }
        const int nig = WGM * nN, gid = wgid / nig, fm = gid * WGM, gsz = (nM - fm) < WGM ? (nM - fm) : WGM;
        u.pm = fm + ((wgid % nig) % gsz); u.pn = (wgid % nig) / gsz; return true;
    }
};

__device__ __forceinline__ unsigned cvt_pk_bf16(float lo, float hi) { unsigned r; asm volatile("v_cvt_pk_bf16_f32 %0, %1, %2" : "=v"(r) : "v"(lo), "v"(hi)); return r; }

template <class Epi, class Sched, bool ALIGN_EPI>
__device__ __forceinline__ void gemm_phase(PG8_LAS unsigned char* lds, const Gemm g, const Sched& S, const Epi& E) {
    const int tid = threadIdx.x, wid = __builtin_amdgcn_readfirstlane(tid >> 6), lane = tid & 63, wr = wid >> 2, wc = wid & 3, fr = lane & 15, fq = lane >> 4;
    const int K = g.K, nt = K / BK;
    unsigned voffA[2], voffB[2];
#pragma unroll
    for (int i = 0; i < 2; ++i) { int R, C; stage_rc(tid * 16 + i * 8192, R, C); const int Rb = Epi::PERM ? ((R & ~31) + perm32(R & 31)) : R;
        voffA[i] = (unsigned)(R * g.lda + C) * 2u; voffB[i] = (unsigned)(Rb * g.ldb + C) * 2u; }
    const size_t kstep = (size_t)(BK * 2);
    const size_t hstepA = (size_t)HALF * g.lda * 2, hstepB = (size_t)HALF * g.ldb * 2;
    const size_t tstepA = 2 * hstepA, tstepB = 2 * hstepB;
    const unsigned ldsw = (unsigned)wid * 1024u;
    const int aoff = lds_byte(wr * 64 + fr, fq * 8), boff = lds_byte(wc * 32 + fr, fq * 8);
#define PG8_SA(b, h) (((b) * 2 + (h)) * HTB)
#define PG8_SB(b, h) ((4 + (b) * 2 + (h)) * HTB)
#define PG8_STAGE(bufoff, gbase, voff) do { _Pragma("unroll") for (int _i = 0; _i < 2; ++_i) \
        __builtin_amdgcn_global_load_lds((const unsigned*)((const char*)(gbase) + (voff)[_i]), (PG8_LAS unsigned*)(lds + (bufoff) + ldsw + _i * 8192), 16, 0, 0); } while (0)
#define PG8_LDA(dst, b, h) do { _Pragma("unroll") for (int m = 0; m < 4; ++m) _Pragma("unroll") for (int k = 0; k < 2; ++k) dst[m][k] = *(const PG8_LAS bf16x8*)(lds + PG8_SA(b, h) + aoff + m * 2048 + k * 1024); } while (0)
#define PG8_LDB(dst, b, h) do { _Pragma("unroll") for (int n = 0; n < 2; ++n) _Pragma("unroll") for (int k = 0; k < 2; ++k) dst[n][k] = *(const PG8_LAS bf16x8*)(lds + PG8_SB(b, h) + boff + n * 2048 + k * 1024); } while (0)
#define PG8_MMA(ai, bj, At, Bt) do { __builtin_amdgcn_s_setprio(1); _Pragma("unroll") for (int m = 0; m < 4; ++m) _Pragma("unroll") for (int n = 0; n < 2; ++n) _Pragma("unroll") for (int k = 0; k < 2; ++k) \
        acc[ai][bj][m][n] = __builtin_amdgcn_mfma_f32_16x16x32_bf16(Bt[n][k], At[m][k], acc[ai][bj][m][n], 0, 0, 0); __builtin_amdgcn_s_setprio(0); } while (0)
#define PG8_WAIT_V(n) asm volatile("s_waitcnt vmcnt(" #n ")" ::: "memory")
#define PG8_WAIT_L(n) asm volatile("s_waitcnt lgkmcnt(" #n ")" ::: "memory")
#define PG8_BAR __builtin_amdgcn_s_barrier()
#define PG8_SCHED __builtin_amdgcn_sched_barrier(0)
#define PG8_AOFF(u) ((size_t)(((u).pn >> g.apn_shift) * g.apn_elems) * 2)
    Unit cur, nxt; int ui = 0;
    if (!S.next(0, cur)) return;
    f32x4 acc[2][2][4][2];
#pragma unroll
    for (int a = 0; a < 2; ++a)
#pragma unroll
        for (int b = 0; b < 2; ++b)
#pragma unroll
            for (int m = 0; m < 4; ++m)
#pragma unroll
                for (int n = 0; n < 2; ++n) acc[a][b][m][n] = (f32x4){0.f, 0.f, 0.f, 0.f};
    bf16x8 At[4][2], B0[2][2], B1[2][2];
    const char* cA = (const char*)g.A + (size_t)cur.pm * tstepA + PG8_AOFF(cur); const char* cB = (const char*)g.Bt + (size_t)cur.pn * tstepB;
    PG8_STAGE(PG8_SB(0, 0), cB, voffB); PG8_STAGE(PG8_SB(0, 1), cB + hstepB, voffB); PG8_STAGE(PG8_SA(0, 0), cA, voffA); PG8_STAGE(PG8_SA(0, 1), cA + hstepA, voffA);
    if (wr == 1) PG8_BAR;
    PG8_WAIT_V(2); PG8_BAR;
    PG8_STAGE(PG8_SB(1, 0), cB + kstep, voffB); PG8_STAGE(PG8_SA(1, 0), cA + kstep, voffA); PG8_STAGE(PG8_SB(1, 1), cB + hstepB + kstep, voffB);
    PG8_WAIT_V(6); PG8_BAR;
    for (;;) {
        const bool has_next = S.next(ui + 1, nxt);
        const char* nA = has_next ? (const char*)g.A + (size_t)nxt.pm * tstepA + PG8_AOFF(nxt) : cA; const char* nB = has_next ? (const char*)g.Bt + (size_t)nxt.pn * tstepB : cB;
        for (int t = 0; t < nt; t += 2) {
            const bool last = (t == nt - 2);
            const char* a1 = cA + (size_t)(t + 1) * kstep;
            const char* a2 = last ? nA : cA + (size_t)(t + 2) * kstep; const char* b2 = last ? nB : cB + (size_t)(t + 2) * kstep;
            const char* a3 = a2 + kstep; const char* b3 = b2 + kstep;
            PG8_LDB(B0, 0, 0); PG8_LDB(B1, 0, 1); PG8_SCHED; PG8_LDA(At, 0, 0); PG8_STAGE(PG8_SA(1, 1), a1 + hstepA, voffA);
            PG8_WAIT_V(8); PG8_WAIT_L(0); PG8_BAR; PG8_MMA(0, 0, At, B0); PG8_MMA(0, 1, At, B1); PG8_BAR; PG8_SCHED;
            PG8_LDA(At, 0, 1); PG8_STAGE(PG8_SB(0, 0), b2, voffB); PG8_STAGE(PG8_SB(0, 1), b2 + hstepB, voffB); PG8_STAGE(PG8_SA(0, 0), a2, voffA);
            PG8_WAIT_V(8); PG8_WAIT_L(0); PG8_BAR; PG8_MMA(1, 0, At, B0); PG8_MMA(1, 1, At, B1); PG8_BAR; PG8_SCHED;
            PG8_LDB(B0, 1, 0); PG8_LDB(B1, 1, 1); PG8_SCHED; PG8_LDA(At, 1, 0); PG8_STAGE(PG8_SA(0, 1), a2 + hstepA, voffA);
            PG8_WAIT_V(8); PG8_WAIT_L(0); PG8_BAR; PG8_MMA(0, 0, At, B0); PG8_MMA(0, 1, At, B1); PG8_BAR; PG8_SCHED;
            PG8_LDA(At, 1, 1); PG8_STAGE(PG8_SB(1, 0), b3, voffB); PG8_STAGE(PG8_SB(1, 1), b3 + hstepB, voffB); PG8_STAGE(PG8_SA(1, 0), a3, voffA);
            PG8_WAIT_V(8); PG8_WAIT_L(0); PG8_BAR; PG8_MMA(1, 0, At, B0); PG8_MMA(1, 1, At, B1); PG8_BAR; PG8_SCHED;
        }
        if constexpr (ALIGN_EPI) { if (wr == 0) PG8_BAR; }
        E(acc, cur, wr, wc, fr, fq);
        if (!has_next) break;
#pragma unroll
        for (int a = 0; a < 2; ++a)
#pragma unroll
            for (int b = 0; b < 2; ++b)
#pragma unroll
                for (int m = 0; m < 4; ++m)
#pragma unroll
                    for (int n = 0; n < 2; ++n) acc[a][b][m][n] = (f32x4){0.f, 0.f, 0.f, 0.f};
        cur = nxt; cA = nA; cB = nB; ++ui;
        if constexpr (ALIGN_EPI) { if (wr == 1) PG8_BAR; }
    }
    PG8_WAIT_V(0);
    if constexpr (!ALIGN_EPI) { if (wr == 0) PG8_BAR; }
    PG8_BAR;
#undef PG8_SA
#undef PG8_SB
#undef PG8_STAGE
#undef PG8_LDA
#undef PG8_LDB
#undef PG8_MMA
#undef PG8_WAIT_V
#undef PG8_WAIT_L
#undef PG8_BAR
#undef PG8_SCHED
#undef PG8_AOFF
}
}

#define LAS __attribute__((address_space(3)))
typedef unsigned short bf16_t;
typedef unsigned v4u __attribute__((ext_vector_type(4)));
typedef unsigned v2u __attribute__((ext_vector_type(2)));
typedef float f32x4 __attribute__((ext_vector_type(4)));
typedef short bf16x8 __attribute__((ext_vector_type(8)));

constexpr int D = 1024, TP = 2048, TS = 64, NBP = 16, NBS = 32;
constexpr int MP = NBP * TP;
constexpr int MS = NBS * TS;
constexpr int M = MP + MS;
constexpr float EPS = 1e-6f;
constexpr size_t O_Y = 0, O_CONVP = 35651584, O_HP = 35700736, O_KP = 35717120, O_VP = 35979264, O_CONVS = 36241408, O_HS = 36339712, O_KS = 36372480, O_VS = 36896768;
constexpr size_t MiB = 1u << 20;
constexpr size_t WS_WINA = 1 * MiB, WS_WGATE = 5 * MiB, WS_WOUTA = 6 * MiB, WS_WB = 8 * MiB, WS_WOUTB = 13 * MiB, WS_SS = 15 * MiB, WS_CP = 16 * MiB, WS_CH = 19 * MiB,
                 WS_KC = 22 * MiB, WS_VTC = 23 * MiB, WS_VTS = 24 * MiB, WS_KB = 25 * MiB, WS_VTP = 34 * MiB, WS_R1 = 48 * MiB, WS_R2 = 116 * MiB, WS_R3 = 252 * MiB, WS_END = 388 * MiB;
constexpr int LDS_BYTES = 135168;
constexpr int NPH = 10;

__device__ __forceinline__ unsigned pk2(float lo, float hi) { return pg8::cvt_pk_bf16(lo, hi); }
__device__ __forceinline__ float bflo(unsigned w) { return __uint_as_float(w << 16); }
__device__ __forceinline__ float bfhi(unsigned w) { return __uint_as_float(w & 0xffff0000u); }
__device__ __forceinline__ float bf2f(bf16_t b) { return __uint_as_float((unsigned)b << 16); }
__device__ __forceinline__ float sigmoidf_(float x) { return __builtin_amdgcn_rcpf(1.0f + __expf(-x)); }
__device__ __forceinline__ float wave_sum(float v) {
#pragma unroll
    for (int o = 1; o < 64; o <<= 1) v += __shfl_xor(v, o);
    return v;
}

using pg8::Unit;
struct EpiStore {
    static constexpr bool PERM = true;
    bf16_t* O; int ldc;
    __device__ __forceinline__ void operator()(const f32x4 (&acc)[2][2][4][2], const Unit& u, int wr, int wc, int fr_, int fq_) const {
        int fr = fr_, fq = fq_; asm volatile("" : "+v"(fr), "+v"(fq));
        const int row0 = u.pm * 256 + wr * 64 + fr, col0 = u.pn * 256 + wc * 32 + 8 * fq;
#pragma unroll
        for (int ai = 0; ai < 2; ++ai)
#pragma unroll
            for (int m = 0; m < 4; ++m) { bf16_t* rowp = O + (size_t)(row0 + ai * 128 + m * 16) * ldc + col0;
#pragma unroll
                for (int bj = 0; bj < 2; ++bj) { const f32x4 v0 = acc[ai][bj][m][0], v1 = acc[ai][bj][m][1];
                    v4u w; w.x = pk2(v0[0], v0[1]); w.y = pk2(v0[2], v0[3]); w.z = pk2(v1[0], v1[1]); w.w = pk2(v1[2], v1[3]);
                    *(v4u*)(rowp + bj * 128) = w; } }
    }
};
struct EpiGate {
    static constexpr bool PERM = true;
    const bf16_t* XC; const float* bgx; const float* bga; const float* lam; unsigned* AB;
    __device__ __forceinline__ void operator()(const f32x4 (&acc)[2][2][4][2], const Unit& u, int wr, int wc, int fr_, int fq_) const {
        int fr = fr_, fq = fq_; asm volatile("" : "+v"(fr), "+v"(fq));
        const int row0 = u.pm * 256 + wr * 64 + fr, ch0 = u.pn * 128 + wc * 32 + 8 * fq;
#pragma unroll
        for (int ai = 0; ai < 2; ++ai)
#pragma unroll
            for (int m = 0; m < 4; ++m) { const size_t off = (size_t)(row0 + ai * 128 + m * 16) * D + ch0;
                asm volatile("" ::: "memory");
                const v4u xw = *(const v4u*)(XC + off);
                float xc[8] = {bflo(xw.x), bfhi(xw.x), bflo(xw.y), bfhi(xw.y), bflo(xw.z), bfhi(xw.z), bflo(xw.w), bfhi(xw.w)};
#pragma unroll
                for (int n = 0; n < 2; ++n) { const f32x4 t0 = *(const f32x4*)(bgx + ch0 + 4 * n), t1 = *(const f32x4*)(bga + ch0 + 4 * n), t2 = *(const f32x4*)(lam + ch0 + 4 * n);
                    unsigned ow[4];
#pragma unroll
                    for (int e = 0; e < 4; ++e) {
                        const float ig = sigmoidf_(acc[ai][0][m][n][e] + t0[e]);
                        const float rg = sigmoidf_(acc[ai][1][m][n][e] + t1[e]);
                        const float la = t2[e] * rg;
                        const float a = __expf(la);
                        const float mult = sqrtf(fmaxf(1.0f - a * a, 0.f));
                        const float bxv = mult * ig * xc[4 * n + e];
                        const _Float16 lh = (_Float16)la;
                        ow[e] = (unsigned)__builtin_bit_cast(unsigned short, lh) | (pk2(bxv, bxv) & 0xffff0000u); }
                    *(v4u*)(AB + off + 4 * n) = (v4u){ow[0], ow[1], ow[2], ow[3]};
                    __builtin_amdgcn_sched_barrier(0); } }
    }
};
struct EpiOutA {
    static constexpr bool PERM = true;
    const float* xp; const float* xs; float* X1; bf16_t* X1B; float* SS;
    __device__ __forceinline__ void operator()(const f32x4 (&acc)[2][2][4][2], const Unit& u, int wr, int wc, int fr_, int fq_) const {
        int fr = fr_, fq = fq_; asm volatile("" : "+v"(fr), "+v"(fq));
        const int row0 = u.pm * 256 + wr * 64 + fr, col0 = u.pn * 256 + wc * 32 + 8 * fq;
#pragma unroll
        for (int ai = 0; ai < 2; ++ai)
#pragma unroll
            for (int m = 0; m < 4; ++m) { const int row = row0 + ai * 128 + m * 16;
                asm volatile("" ::: "memory");
                const float* xr = (row < MP) ? xp + (size_t)row * D : xs + (size_t)(row - MP) * D;
                float ssq = 0.f;
#pragma unroll
                for (int bj = 0; bj < 2; ++bj) { const int c = col0 + bj * 128;
                    const f32x4 v0 = acc[ai][bj][m][0] + *(const f32x4*)(xr + c), v1 = acc[ai][bj][m][1] + *(const f32x4*)(xr + c + 4);
                    *(f32x4*)(X1 + (size_t)row * D + c) = v0; *(f32x4*)(X1 + (size_t)row * D + c + 4) = v1;
                    v4u w; w.x = pk2(v0[0], v0[1]); w.y = pk2(v0[2], v0[3]); w.z = pk2(v1[0], v1[1]); w.w = pk2(v1[2], v1[3]);
                    *(v4u*)(X1B + (size_t)row * D + c) = w;
                    ssq += (v0[0] * v0[0] + v0[1] * v0[1]) + (v0[2] * v0[2] + v0[3] * v0[3]) + (v1[0] * v1[0] + v1[1] * v1[1]) + (v1[2] * v1[2] + v1[3] * v1[3]); }
                ssq += __shfl_xor(ssq, 16); ssq += __shfl_xor(ssq, 32);
                if (fq == 0) atomicAdd(SS + row, ssq); }
    }
};
struct EpiB {
    static constexpr bool PERM = true;
    const float* SS; const float* qg; const float* kg; bf16_t* QB; bf16_t* GB; bf16_t* KB; bf16_t* VTP; bf16_t* VTS; float* out;
    __device__ __forceinline__ void operator()(const f32x4 (&acc)[2][2][4][2], const Unit& u, int wr, int wc, int fr_, int fq_) const {
        int fr = fr_, fq = fq_; asm volatile("" : "+v"(fr), "+v"(fq));
        const int Hd = 4 * u.pn + wc, row0 = u.pm * 256 + wr * 64 + fr;
        const bool normed = (Hd < 16) || (Hd == 32) || (Hd == 33);
        const float* gsrc = (Hd < 16) ? qg : kg; const float gscale = (Hd < 16) ? 0.125f : 1.0f;
#pragma unroll
        for (int ai = 0; ai < 2; ++ai)
#pragma unroll
            for (int m = 0; m < 4; ++m) { const int row = row0 + ai * 128 + m * 16;
                asm volatile("" ::: "memory");
                const float rs = rsqrtf(SS[row] * (1.0f / D) + EPS);
                float v[2][8];
#pragma unroll
                for (int bj = 0; bj < 2; ++bj)
#pragma unroll
                    for (int n = 0; n < 2; ++n)
#pragma unroll
                        for (int e = 0; e < 4; ++e) v[bj][4 * n + e] = acc[ai][bj][m][n][e] * rs;
                if (normed) {
                    float ssq = 0.f;
#pragma unroll
                    for (int bj = 0; bj < 2; ++bj)
#pragma unroll
                        for (int e = 0; e < 8; ++e) ssq += v[bj][e] * v[bj][e];
                    ssq += __shfl_xor(ssq, 16); ssq += __shfl_xor(ssq, 32);
                    const float hn = rsqrtf(ssq * (1.0f / 64.0f) + EPS) * gscale;
#pragma unroll
                    for (int bj = 0; bj < 2; ++bj) { const f32x4 g0 = *(const f32x4*)(gsrc + 32 * bj + 8 * fq), g1 = *(const f32x4*)(gsrc + 32 * bj + 8 * fq + 4);
#pragma unroll
                        for (int e = 0; e < 4; ++e) { v[bj][e] *= hn * g0[e]; v[bj][4 + e] *= hn * g1[e]; } }
                }
                if (Hd < 32) {
                    if (Hd >= 16) {
#pragma unroll
                        for (int bj = 0; bj < 2; ++bj)
#pragma unroll
                            for (int e = 0; e < 8; ++e) v[bj][e] = v[bj][e] * sigmoidf_(v[bj][e]);
                    }
                    bf16_t* dst = ((Hd < 16) ? QB : GB) + (size_t)row * D + (Hd & 15) * 64 + 8 * fq;
#pragma unroll
                    for (int bj = 0; bj < 2; ++bj) { v4u w; w.x = pk2(v[bj][0], v[bj][1]); w.y = pk2(v[bj][2], v[bj][3]); w.z = pk2(v[bj][4], v[bj][5]); w.w = pk2(v[bj][6], v[bj][7]);
                        *(v4u*)(dst + 32 * bj) = w; }
                } else {
                    const int h = Hd & 1; const bool isv = Hd >= 34;
                    float* od = nullptr; int sq, t;
                    if (row < MP) { sq = row >> 11; t = row & 2047; if (t >= TP - 128) od = out + (isv ? O_VP : O_KP) + ((size_t)(sq * 128 + (t - (TP - 128))) * 2 + h) * 64; }
                    else { sq = (row - MP) >> 6; t = (row - MP) & 63; od = out + (isv ? O_VS : O_KS) + ((size_t)(sq * 128 + 64 + t) * 2 + h) * 64; }
                    if (od) {
#pragma unroll
                        for (int bj = 0; bj < 2; ++bj) { float* p = od + 32 * bj + 8 * fq;
                            *(f32x4*)p = (f32x4){v[bj][0], v[bj][1], v[bj][2], v[bj][3]}; *(f32x4*)(p + 4) = (f32x4){v[bj][4], v[bj][5], v[bj][6], v[bj][7]}; }
                    }
                    if (!isv) {
                        bf16_t* dst = KB + (size_t)row * 128 + h * 64 + 8 * fq;
#pragma unroll
                        for (int bj = 0; bj < 2; ++bj) { v4u w; w.x = pk2(v[bj][0], v[bj][1]); w.y = pk2(v[bj][2], v[bj][3]); w.z = pk2(v[bj][4], v[bj][5]); w.w = pk2(v[bj][6], v[bj][7]);
                            *(v4u*)(dst + 32 * bj) = w; }
                    } else {
                        bf16_t* vb; int pitch;
                        if (row < MP) { vb = VTP + (size_t)((sq * 2 + h) * 64) * TP + t; pitch = TP; } else { vb = VTS + (size_t)((sq * 2 + h) * 64) * TS + t; pitch = TS; }
#pragma unroll
                        for (int bj = 0; bj < 2; ++bj)
#pragma unroll
                            for (int e = 0; e < 8; ++e) vb[(size_t)(32 * bj + 8 * fq + e) * pitch] = (bf16_t)(pk2(v[bj][e], v[bj][e]) & 0xffffu);
                    }
                }
            }
    }
};
struct EpiOutB {
    static constexpr bool PERM = true;
    float* Y;
    __device__ __forceinline__ void operator()(const f32x4 (&acc)[2][2][4][2], const Unit& u, int wr, int wc, int fr_, int fq_) const {
        int fr = fr_, fq = fq_; asm volatile("" : "+v"(fr), "+v"(fq));
        const int row0 = u.pm * 256 + wr * 64 + fr, col0 = u.pn * 256 + wc * 32 + 8 * fq;
#pragma unroll
        for (int ai = 0; ai < 2; ++ai)
#pragma unroll
            for (int m = 0; m < 4; ++m) { float* yr = Y + (size_t)(row0 + ai * 128 + m * 16) * D + col0;
                asm volatile("" ::: "memory");
#pragma unroll
                for (int bj = 0; bj < 2; ++bj) { float* p = yr + bj * 128;
                    const f32x4 v0 = acc[ai][bj][m][0] + *(const f32x4*)p, v1 = acc[ai][bj][m][1] + *(const f32x4*)(p + 4);
                    *(f32x4*)p = v0; *(f32x4*)(p + 4) = v1; } }
    }
};

struct RmId { __device__ __forceinline__ int operator()(int n) const { return n; } };
struct RmGate { int g, isA; __device__ __forceinline__ int operator()(int n) const { return 256 * (2 * g + (n >> 7)) + (n & 127) + (isA ? 128 : 0); } };
struct RmHead { int head0; __device__ __forceinline__ int operator()(int n) const { const int H = head0 + (n >> 6), j = n & 63; return 256 * (H >> 2) + 128 * (j >> 5) + 32 * (H & 3) + (j & 31); } };
template <class RM>
__device__ __forceinline__ void transpose_item(const float* W, int ldw, int nblk, const float* gain, bf16_t* WT, int ldt, const RM rm, LAS float* scr, int item, int lane) {
    const int kb = item / nblk, nb = item % nblk, k0 = 64 * kb, n0 = 32 * nb;
#pragma unroll 8
    for (int i = 0; i < 32; ++i) { const int kk = 2 * i + (lane >> 5); const float gsc = gain ? gain[k0 + kk] : 1.0f; scr[kk * 33 + (lane & 31)] = W[(size_t)(k0 + kk) * ldw + n0 + (lane & 31)] * gsc; }
    asm volatile("s_waitcnt lgkmcnt(0)" ::: "memory");
    const int c = lane & 7;
#pragma unroll
    for (int j = 0; j < 4; ++j) { const int n = (lane >> 3) + 8 * j; const LAS float* s = scr + (8 * c) * 33 + n;
        v4u o; o.x = pk2(s[0 * 33], s[1 * 33]); o.y = pk2(s[2 * 33], s[3 * 33]); o.z = pk2(s[4 * 33], s[5 * 33]); o.w = pk2(s[6 * 33], s[7 * 33]);
        *(v4u*)(WT + (size_t)rm(n0 + n) * ldt + k0 + 8 * c) = o; }
    asm volatile("s_waitcnt lgkmcnt(0)" ::: "memory");
}


#define XB_TMO      128
#define XB_XCNT(j)  (256  + 64 * (j))
#define XB_XSUB(j)  (1280 + 64 * (j))
#define XB_XGEN(j)  (2304 + 64 * (j))
#define XB_TOP      3328
#define XB_TOPGEN   3392
#define XCD_BAR_WORDS 3456
#define XB_SPIN_CAP (1u << 22)
__device__ __forceinline__ unsigned xb_ld(unsigned* p)              { return __hip_atomic_load(p, __ATOMIC_RELAXED, __HIP_MEMORY_SCOPE_AGENT); }
__device__ __forceinline__ unsigned xb_add(unsigned* p, unsigned v) { return __hip_atomic_fetch_add(p, v, __ATOMIC_RELAXED, __HIP_MEMORY_SCOPE_AGENT); }
__device__ __forceinline__ unsigned xb_xcc_id() { return (unsigned)__builtin_amdgcn_s_getreg((3 << 11) | 20) & 0xFu; }
#define XB_SPIN(cond, bar) do { unsigned _sp = 0; while (cond) { __builtin_amdgcn_s_sleep(1); \
    if ((++_sp & 255u) == 0u) { if (xb_ld(&(bar)[XB_TMO])) break; if (_sp > XB_SPIN_CAP) { atomicAdd(&(bar)[XB_TMO], 1u); break; } } } } while (0)
struct XcdBarrier { unsigned* bar; unsigned x; volatile LAS unsigned* st; };
__device__ __forceinline__ XcdBarrier xcd_barrier_post(unsigned* bar, volatile LAS unsigned* st) {
    XcdBarrier b; b.bar = bar; b.x = xb_xcc_id(); b.st = st;
    if (threadIdx.x == 0) (void)xb_add(&bar[XB_XCNT(b.x)], 1u);
    return b;
}
__device__ __forceinline__ void xcd_barrier_complete(unsigned* bar, unsigned x, unsigned& nloc, unsigned& nx) {
    const unsigned G = gridDim.x * gridDim.y * gridDim.z;
    unsigned sum, cnt, mine, sp = 0u;
    for (;;) {
        sum = 0u; cnt = 0u; mine = 0u;
#pragma unroll
        for (unsigned j = 0; j < 16; ++j) { const unsigned c = xb_ld(&bar[XB_XCNT(j)]); sum += c; cnt += (c > 0u) ? 1u : 0u; mine = (j == x) ? c : mine; }
        if (sum == G) break;
        __builtin_amdgcn_s_sleep(1);
        if ((++sp & 255u) == 0u) { if (xb_ld(&bar[XB_TMO])) break; if (sp > XB_SPIN_CAP) { atomicAdd(&bar[XB_TMO], 1u); break; } }
    }
    nloc = mine > 0u ? mine : 1u; nx = cnt > 0u ? cnt : 1u;
}
__device__ __forceinline__ void xcd_barrier(const XcdBarrier& b) {
    asm volatile("s_waitcnt vmcnt(0)" ::: "memory");
    __syncthreads();
    if (threadIdx.x == 0) {
        unsigned* bar = b.bar;
        __builtin_amdgcn_s_waitcnt(0);
        unsigned nloc = b.st[0], nx = b.st[1];
        if (nloc == 0u) { xcd_barrier_complete(bar, b.x, nloc, nx); b.st[0] = nloc; b.st[1] = nx; }
        const unsigned old = xb_add(&bar[XB_XSUB(b.x)], 1u);
        const unsigned gen = old / nloc;
        if (old + 1u == (gen + 1u) * nloc) {
            __builtin_amdgcn_fence(__ATOMIC_RELEASE, "agent");
            asm volatile("s_waitcnt vmcnt(0)" ::: "memory");
            const unsigned og = xb_add(&bar[XB_TOP], 1u);
            const unsigned tg = og / nx;
            if (og + 1u == (tg + 1u) * nx) xb_add(&bar[XB_TOPGEN], 1u);
            else XB_SPIN(xb_ld(&bar[XB_TOPGEN]) == tg, bar);
            __builtin_amdgcn_fence(__ATOMIC_ACQUIRE, "agent");
            xb_add(&bar[XB_XGEN(b.x)], 1u);
            asm volatile("s_waitcnt vmcnt(0)" ::: "memory");
        } else {
            XB_SPIN(xb_ld(&bar[XB_XGEN(b.x)]) == gen, bar);
            __builtin_amdgcn_fence(__ATOMIC_ACQUIRE, "agent");
            asm volatile("s_waitcnt vmcnt(0)" ::: "memory");
        }
    }
    __syncthreads();
}

struct Args { const float* in[24]; float* out; unsigned char* ws; int ph_lo, ph_hi; };

__global__ void __launch_bounds__(512, 2) yoco_fwd(Args args) {
    extern __shared__ __attribute__((aligned(16))) unsigned char lds_raw[];
    LAS unsigned char* lds = (LAS unsigned char*)lds_raw;
    const int tid = threadIdx.x, lane = tid & 63, wave = __builtin_amdgcn_readfirstlane(tid >> 6);
    const int G = gridDim.x, bid = blockIdx.x;
    const int gw = bid * 8 + wave, NGW = G * 8;
    const int gtid = bid * 512 + tid, NT = G * 512;
    unsigned char* ws = args.ws; float* out = args.out;
typedef const float* cfp_t;
#define ARGP(k) (((cfp_t const volatile __attribute__((address_space(4)))*)__builtin_amdgcn_kernarg_segment_ptr())[k])
    bf16_t* WT_INA = (bf16_t*)(ws + WS_WINA); bf16_t* WT_GATE = (bf16_t*)(ws + WS_WGATE); bf16_t* WT_OUTA = (bf16_t*)(ws + WS_WOUTA);
    bf16_t* WT_B = (bf16_t*)(ws + WS_WB); bf16_t* WT_OUTB = (bf16_t*)(ws + WS_WOUTB);
    float* SS = (float*)(ws + WS_SS); float* CL = (float*)(ws + WS_SS + 512 * 1024); float* CP = (float*)(ws + WS_CP); float* CH = (float*)(ws + WS_CH);
    bf16_t* KC = (bf16_t*)(ws + WS_KC); bf16_t* VTC = (bf16_t*)(ws + WS_VTC); bf16_t* VTS = (bf16_t*)(ws + WS_VTS);
    bf16_t* KB = (bf16_t*)(ws + WS_KB); bf16_t* VTP = (bf16_t*)(ws + WS_VTP);
    bf16_t* XN = (bf16_t*)(ws + WS_R1); bf16_t* XC = XN; bf16_t* HG = XN;
    bf16_t* U = (bf16_t*)(ws + WS_R2); bf16_t* X1B = U;
    unsigned* AB = (unsigned*)(ws + WS_R3); bf16_t* QB = (bf16_t*)(ws + WS_R3); bf16_t* GB = QB + (size_t)M * D;
    const int lo = args.ph_lo, hi = args.ph_hi;
#ifdef ONLYPH
#define IN(k) ((k) == ONLYPH && lo <= (k) && (k) < hi)
#else
#define IN(k) (lo <= (k) && (k) < hi)
#endif
#if MK_SINGLE
    volatile LAS unsigned* MISC = (volatile LAS unsigned*)(lds + 131072);
    if (tid < 64) MISC[tid] = 0u;
    __syncthreads();
    const XcdBarrier bar = xcd_barrier_post((unsigned*)ws, MISC + 8);
    cg::this_grid().sync();
#define SEAM(k) do { if (IN(k) && IN((k) + 1)) xcd_barrier(bar); } while (0)
#else
#define SEAM(k) do { } while (0)
#endif

    if (IN(0)) for (int rep_ = 0; rep_ < REPS(0); ++rep_) {
        const float* xp = ARGP(0); const float* xs = ARGP(1); const float* cache_k = ARGP(4); const float* cache_v = ARGP(5); const float* norm_a = ARGP(6); const float* w_in_a = ARGP(7);
        const float* w_gx = ARGP(10); const float* w_ga = ARGP(12); const float* lam = ARGP(14); const float* w_out_a = ARGP(15); const float* norm_kv = ARGP(16); const float* w_kv = ARGP(17);
        const float* norm_b = ARGP(19); const float* w_in_b = ARGP(20); const float* w_out_b = ARGP(23);
        LAS float* scr = (LAS float*)(lds + wave * 16384);
        constexpr int NITEMS = 1024 + 256 + 512 + 1024 + 128 + 512;
        for (int it = gw; it < NITEMS; it += NGW) {
            int r = it;
            if (r < 1024) { transpose_item(w_in_a, 2048, 64, norm_a, WT_INA, 1024, RmId{}, scr, r, lane); continue; } r -= 1024;
            if (r < 256) { const int gm = r >> 5, gi = gm & 3, isA = gm >> 2; transpose_item((isA ? w_ga : w_gx) + (size_t)gi * 65536, 256, 8, nullptr, WT_GATE, 256, RmGate{gi, isA}, scr, r & 31, lane); continue; } r -= 256;
            if (r < 512) { transpose_item(w_out_a, 1024, 32, nullptr, WT_OUTA, 1024, RmId{}, scr, r, lane); continue; } r -= 512;
            if (r < 1024) { transpose_item(w_in_b, 2048, 64, norm_b, WT_B, 1024, RmHead{0}, scr, r, lane); continue; } r -= 1024;
            if (r < 128) { transpose_item(w_kv, 256, 8, norm_kv, WT_B, 1024, RmHead{32}, scr, r, lane); continue; } r -= 128;
            transpose_item(w_out_b, 1024, 32, nullptr, WT_OUTB, 1024, RmId{}, scr, r, lane);
        }
        for (int m = 2 * gw; m < M; m += 2 * NGW) {
            const float* xrow0 = (m < MP) ? xp + (size_t)m * D : xs + (size_t)(m - MP) * D;
            const f32x4* xr0 = (const f32x4*)xrow0 + lane; const f32x4* xr1 = xr0 + 256;
            f32x4 v[4], w[4]; float s0 = 0.f, s1 = 0.f;
#pragma unroll
            for (int j = 0; j < 4; ++j) { v[j] = xr0[64 * j]; w[j] = xr1[64 * j]; }
#pragma unroll
            for (int j = 0; j < 4; ++j) { s0 += (v[j].x * v[j].x + v[j].y * v[j].y) + (v[j].z * v[j].z + v[j].w * v[j].w); s1 += (w[j].x * w[j].x + w[j].y * w[j].y) + (w[j].z * w[j].z + w[j].w * w[j].w); }
            const float rs0 = rsqrtf(wave_sum(s0) * (1.0f / D) + EPS), rs1 = rsqrtf(wave_sum(s1) * (1.0f / D) + EPS);
            v2u* o0 = (v2u*)(XN + (size_t)m * D) + lane; v2u* o1 = o0 + 256;
#pragma unroll
            for (int j = 0; j < 4; ++j) { o0[64 * j] = (v2u){pk2(v[j].x * rs0, v[j].y * rs0), pk2(v[j].z * rs0, v[j].w * rs0)}; o1[64 * j] = (v2u){pk2(w[j].x * rs1, w[j].y * rs1), pk2(w[j].z * rs1, w[j].w * rs1)}; }
        }
        for (int i = gtid; i < M; i += NT) SS[i] = 0.f;
        for (int i = gtid; i < D; i += NT) { const float l = lam[i]; CL[i] = 8.0f * (fminf(l, 0.f) - log1pf(__expf(-fabsf(l)))); }
        for (int i = gtid; i < NBS * 128 * 128; i += NT) { KC[i] = (bf16_t)(pk2(cache_k[i], 0.f) & 0xffffu);
            const int t = i & 127, d = (i >> 7) & 63, h = (i >> 13) & 1, b = i >> 14;
            VTC[i] = (bf16_t)(pk2(cache_v[((size_t)(b * 128 + t) * 2 + h) * 64 + d], 0.f) & 0xffffu); }
        for (int i = gtid; i < NBS * 64 * 128; i += NT) { const int b = i >> 13, rem = i & 8191;
            out[O_KS + (size_t)b * 16384 + rem] = cache_k[(size_t)b * 16384 + 8192 + rem];
            out[O_VS + (size_t)b * 16384 + rem] = cache_v[(size_t)b * 16384 + 8192 + rem]; }
        __syncthreads();
    }
    SEAM(0);

    if (IN(1)) for (int rep_ = 0; rep_ < REPS(1); ++rep_) {
        pg8::Gemm g{XN, WT_INA, M, 2048, 1024, 1024, 1024, 0, 0}; pg8::StaticOrder S; S.init(M, 2048, G, bid);
        EpiStore E{U, 2048};
        pg8::gemm_phase<EpiStore, pg8::StaticOrder, true>(lds, g, S, E);
    }
    SEAM(1);

    if (IN(2)) for (int rep_ = 0; rep_ < REPS(2); ++rep_) {
        const float* state_conv = ARGP(2); const float* conv_w = ARGP(8); const float* conv_b = ARGP(9);
        for (int it = gw; it < (M / 16) * 2; it += NGW) {
            const int row0 = (it >> 1) * 16, c0 = (it & 1) * 512 + lane * 8;
            int t0, T; const float* st = nullptr; float* cso;
            if (row0 < MP) { t0 = row0 & 2047; T = TP; cso = out + O_CONVP + (size_t)(row0 >> 11) * 3 * D; }
            else { const int r = row0 - MP; t0 = r & 63; T = TS; st = state_conv + (size_t)(r >> 6) * 3 * D; cso = out + O_CONVS + (size_t)(r >> 6) * 3 * D; }
            float w[4][8], bb[8], xh[3][8];
#pragma unroll
            for (int e = 0; e < 8; ++e) { bb[e] = conv_b[c0 + e];
#pragma unroll
                for (int j = 0; j < 4; ++j) w[j][e] = conv_w[j * D + c0 + e]; }
#pragma unroll
            for (int j = 0; j < 3; ++j) {
                if (t0 == 0) {
#pragma unroll
                    for (int e = 0; e < 8; ++e) xh[j][e] = st ? st[j * D + c0 + e] : 0.f;
                } else {
                    const v4u q = *(const v4u*)(U + (size_t)(row0 - 3 + j) * 2048 + c0);
                    xh[j][0] = bflo(q.x); xh[j][1] = bfhi(q.x); xh[j][2] = bflo(q.y); xh[j][3] = bfhi(q.y); xh[j][4] = bflo(q.z); xh[j][5] = bfhi(q.z); xh[j][6] = bflo(q.w); xh[j][7] = bfhi(q.w);
                }
            }
#pragma unroll
            for (int r = 0; r < 16; ++r) {
                const v4u q = *(const v4u*)(U + (size_t)(row0 + r) * 2048 + c0);
                float x3[8] = {bflo(q.x), bfhi(q.x), bflo(q.y), bfhi(q.y), bflo(q.z), bfhi(q.z), bflo(q.w), bfhi(q.w)};
                float o[8];
#pragma unroll
                for (int e = 0; e < 8; ++e) o[e] = bb[e] + w[0][e] * xh[0][e] + w[1][e] * xh[1][e] + w[2][e] * xh[2][e] + w[3][e] * x3[e];
                *(v4u*)(XC + (size_t)(row0 + r) * D + c0) = (v4u){pk2(o[0], o[1]), pk2(o[2], o[3]), pk2(o[4], o[5]), pk2(o[6], o[7])};
                if (t0 + r >= T - 3) { float* p = cso + (size_t)(t0 + r - (T - 3)) * D + c0;
                    *(f32x4*)p = (f32x4){x3[0], x3[1], x3[2], x3[3]}; *(f32x4*)(p + 4) = (f32x4){x3[4], x3[5], x3[6], x3[7]}; }
#pragma unroll
                for (int e = 0; e < 8; ++e) { xh[0][e] = xh[1][e]; xh[1][e] = xh[2][e]; xh[2][e] = x3[e]; }
            }
        }
        __syncthreads();
    }
    SEAM(2);

    if (IN(3)) for (int rep_ = 0; rep_ < REPS(3); ++rep_) {
        pg8::Gemm g{XC, WT_GATE, M, 2048, 256, 1024, 256, 1, 256}; pg8::StaticOrder S; S.init(M, 2048, G, bid);
        EpiGate E{XC, ARGP(11), ARGP(13), CL, AB};
        pg8::gemm_phase<EpiGate, pg8::StaticOrder, true>(lds, g, S, E);
    }
    SEAM(3);

    if (IN(4)) for (int rep_ = 0; rep_ < REPS(4); ++rep_) {
        for (int it = gw; it < (M / 64) * 16; it += NGW) {
            const int uid = it >> 4, c = (it & 15) * 64 + lane;
            const unsigned* p = AB + (size_t)uid * 64 * D + c;
            float P = 1.f, H = 0.f;
#pragma unroll 1
            for (int r0 = 0; r0 < 64; r0 += 32) {
                unsigned wv[32];
#pragma unroll
                for (int i = 0; i < 32; ++i) wv[i] = p[(size_t)(r0 + i) * D];
#pragma unroll
                for (int i = 0; i < 32; ++i) { const float la = (float)__builtin_bit_cast(_Float16, (unsigned short)(wv[i] & 0xffffu)); const float a = __expf(la);
                    P *= a; H = a * H + bfhi(wv[i]); }
            }
            CP[(size_t)uid * D + c] = P; CH[(size_t)uid * D + c] = H;
        }
        __syncthreads();
    }
    SEAM(4);

    if (IN(5)) for (int rep_ = 0; rep_ < REPS(5); ++rep_) {
        const float* state_h = ARGP(3);
        for (int it = gw; it < (M / 64) * 16; it += NGW) {
            const int uid = it >> 4, c = (it & 15) * 64 + lane;
            int k; float h;
            if (uid < 512) { k = uid & 31; h = 0.f; } else { k = 0; h = state_h[(size_t)(uid - 512) * D + c]; }
            {
                const float* cp0 = CP + (size_t)(uid - k) * D + c; const float* ch0 = CH + (size_t)(uid - k) * D + c;
#pragma unroll 1
                for (int j0 = 0; j0 < k; j0 += 16) {
                    float pa[16], pb[16];
#pragma unroll
                    for (int i = 0; i < 16; ++i) { const bool ok = (j0 + i) < k; pa[i] = ok ? cp0[(size_t)(j0 + i) * D] : 1.0f; pb[i] = ok ? ch0[(size_t)(j0 + i) * D] : 0.0f; }
#pragma unroll
                    for (int i = 0; i < 16; ++i) h = pa[i] * h + pb[i];
                }
            }
            const unsigned* p = AB + (size_t)uid * 64 * D + c;
            const bf16_t* gp = U + (size_t)uid * 64 * 2048 + 1024 + c;
            bf16_t* hp = HG + (size_t)uid * 64 * D + c;
#pragma unroll 1
            for (int r0 = 0; r0 < 64; r0 += 32) {
                unsigned wv[32]; bf16_t gv[32];
#pragma unroll
                for (int i = 0; i < 32; ++i) { wv[i] = p[(size_t)(r0 + i) * D]; gv[i] = gp[(size_t)(r0 + i) * 2048]; }
#pragma unroll
                for (int i = 0; i < 32; ++i) { const float la = (float)__builtin_bit_cast(_Float16, (unsigned short)(wv[i] & 0xffffu)); const float a = __expf(la);
                    h = a * h + bfhi(wv[i]); const float gt = bf2f(gv[i]); const float hg = h * gt * sigmoidf_(gt);
                    hp[(size_t)(r0 + i) * D] = (bf16_t)(pk2(hg, hg) & 0xffffu); }
            }
            if (uid >= 512) out[O_HS + (size_t)(uid - 512) * D + c] = h;
            else if (k == 31) out[O_HP + (size_t)(uid >> 5) * D + c] = h;
        }
        __syncthreads();
    }
    SEAM(5);

    if (IN(6)) for (int rep_ = 0; rep_ < REPS(6); ++rep_) {
        pg8::Gemm g{HG, WT_OUTA, M, 1024, 1024, 1024, 1024, 0, 0}; pg8::StaticOrder S; S.init(M, 1024, G, bid);
        EpiOutA E{ARGP(0), ARGP(1), out + O_Y, X1B, SS};
        pg8::gemm_phase<EpiOutA, pg8::StaticOrder, true>(lds, g, S, E);
    }
    SEAM(6);

    if (IN(7)) for (int rep_ = 0; rep_ < REPS(7); ++rep_) {
        pg8::Gemm g{X1B, WT_B, M, 2304, 1024, 1024, 1024, 0, 0}; pg8::StaticOrder S; S.init(M, 2304, G, bid);
        EpiB E{SS, ARGP(21), ARGP(18), QB, GB, KB, VTP, VTS, out};
        pg8::gemm_phase<EpiB, pg8::StaticOrder, true>(lds, g, S, E);
    }
    SEAM(7);

    if (IN(8)) for (int rep_ = 0; rep_ < REPS(8); ++rep_) {
        const float* sinks = ARGP(22);
        const int i16 = lane & 15, g4 = lane >> 4;
        constexpr int KP = 144, VP = 400, KBYTES = 192 * KP, BUFB = KBYTES + 64 * VP;
        const int rl = tid >> 3, c8 = tid & 7;
        const int kk_s = 32 * (rl >> 5) + 8 * ((rl & 15) >> 2) + (rl & 3) + 4 * ((rl >> 4) & 1);
        const int ksrc = kk_s * 128 + 8 * c8, kdst = rl * KP + 16 * c8, vdst = KBYTES + rl * VP + 16 * c8;
        int row0, kvh; const bf16_t* kp[3]; const bf16_t* vp[3]; int vpitch[3]; bool valid[3];
        v4u kreg[3], vreg[3]; bf16x8 qn[4][2];
#define ATT_DESC(u_) do { if ((u_) < 1024) { const int s_ = (u_) >> 6, c_ = ((u_) >> 1) & 31; kvh = (u_) & 1; row0 = s_ * TP + 64 * c_; \
            _Pragma("unroll") for (int jb = 0; jb < 3; ++jb) { const int cc = c_ - 2 + jb; valid[jb] = cc >= 0; const int ccc = cc < 0 ? 0 : cc; \
                kp[jb] = KB + (size_t)(s_ * TP + 64 * ccc) * 128 + kvh * 64; vp[jb] = VTP + (size_t)((s_ * 2 + kvh) * 64) * TP + 64 * ccc; vpitch[jb] = TP; } \
        } else { const int u2 = (u_) - 1024, b_ = u2 >> 1; kvh = u2 & 1; row0 = MP + 64 * b_; \
            _Pragma("unroll") for (int jb = 0; jb < 2; ++jb) { valid[jb] = true; kp[jb] = KC + (size_t)(b_ * 128 + 64 * jb) * 128 + kvh * 64; vp[jb] = VTC + (size_t)((b_ * 2 + kvh) * 64) * 128 + 64 * jb; vpitch[jb] = 128; } \
            valid[2] = true; kp[2] = KB + (size_t)(MP + 64 * b_) * 128 + kvh * 64; vp[2] = VTS + (size_t)((b_ * 2 + kvh) * 64) * TS; vpitch[2] = TS; } } while (0)
#define ATT_LOAD() do { _Pragma("unroll") for (int jb = 0; jb < 3; ++jb) if (valid[jb]) { kreg[jb] = *(const v4u*)(kp[jb] + ksrc); vreg[jb] = *(const v4u*)(vp[jb] + (size_t)rl * vpitch[jb] + 8 * c8); } \
            _Pragma("unroll") for (int qt = 0; qt < 4; ++qt) { const size_t qoff = (size_t)(row0 + 16 * qt + i16) * D + (kvh * 8 + wave) * 64 + 8 * g4; \
                qn[qt][0] = *(const bf16x8*)(QB + qoff); qn[qt][1] = *(const bf16x8*)(QB + qoff + 32); } } while (0)
        int u = bid, buf = 0;
        if (u < 1088) { ATT_DESC(u); ATT_LOAD(); }
        for (; u < 1088; u += G) {
            LAS unsigned char* L = lds + buf * BUFB;
#pragma unroll
            for (int jb = 0; jb < 3; ++jb) if (valid[jb]) { *(LAS v4u*)(L + jb * 64 * KP + kdst) = kreg[jb]; *(LAS v4u*)(L + vdst + jb * 128) = vreg[jb]; }
            const int row0c = row0, qh = kvh * 8 + wave; const bool v0 = valid[0], v1 = valid[1];
            bf16x8 qf[4][2];
#pragma unroll
            for (int qt = 0; qt < 4; ++qt) { qf[qt][0] = qn[qt][0]; qf[qt][1] = qn[qt][1]; }
            __syncthreads();
            const int un = u + G;
            if (un < 1088) { ATT_DESC(un); ATT_LOAD(); }
            const float sk = sinks[qh];
#pragma unroll
            for (int qt = 0; qt < 4; ++qt) {
                const size_t ooff = (size_t)(row0c + 16 * qt + i16) * D + qh * 64 + 4 * g4;
                v2u gw2[4];
#pragma unroll
                for (int dt = 0; dt < 4; ++dt) gw2[dt] = *(const v2u*)(GB + ooff + 16 * dt);
                f32x4 s[12];
#pragma unroll
                for (int jb = 0; jb < 3; ++jb) {
                    const bool ok = (jb == 0) ? v0 : ((jb == 1) ? v1 : true);
                    if (ok) {
#pragma unroll
                        for (int q2 = 0; q2 < 4; ++q2) {
                            const LAS unsigned char* ka = L + (64 * jb + 16 * q2 + i16) * KP + 16 * g4;
                            const bf16x8 a0 = *(const LAS bf16x8*)ka, a1 = *(const LAS bf16x8*)(ka + 64);
                            f32x4 ac = (f32x4){0.f, 0.f, 0.f, 0.f};
                            ac = __builtin_amdgcn_mfma_f32_16x16x32_bf16(a0, qf[qt][0], ac, 0, 0, 0);
                            ac = __builtin_amdgcn_mfma_f32_16x16x32_bf16(a1, qf[qt][1], ac, 0, 0, 0);
                            s[4 * jb + q2] = ac; }
                    } else {
#pragma unroll
                        for (int q2 = 0; q2 < 4; ++q2) s[4 * jb + q2] = (f32x4){-1e30f, -1e30f, -1e30f, -1e30f};
                    }
                }
                float mx = sk;
#pragma unroll
                for (int kt = 0; kt < 12; ++kt) mx = fmaxf(fmaxf(mx, fmaxf(s[kt][0], s[kt][1])), fmaxf(s[kt][2], s[kt][3]));
                mx = fmaxf(mx, __shfl_xor(mx, 16)); mx = fmaxf(mx, __shfl_xor(mx, 32));
                float sum = 0.f;
#pragma unroll
                for (int kt = 0; kt < 12; ++kt) {
#pragma unroll
                    for (int r = 0; r < 4; ++r) { const float pv = __expf(s[kt][r] - mx); s[kt][r] = pv; sum += pv; } }
                sum += __shfl_xor(sum, 16); sum += __shfl_xor(sum, 32);
                const float inv = 1.0f / (sum + __expf(sk - mx));
                bf16x8 pf[6];
#pragma unroll
                for (int kb = 0; kb < 6; ++kb) { const f32x4 p0 = s[2 * kb] * inv, p1 = s[2 * kb + 1] * inv;
                    const v4u w = (v4u){pk2(p0[0], p0[1]), pk2(p0[2], p0[3]), pk2(p1[0], p1[1]), pk2(p1[2], p1[3])};
                    pf[kb] = __builtin_bit_cast(bf16x8, w); }
#pragma unroll
                for (int dt = 0; dt < 4; ++dt) {
                    f32x4 oc = (f32x4){0.f, 0.f, 0.f, 0.f};
#pragma unroll
                    for (int jb = 0; jb < 3; ++jb) {
                        const bool ok = (jb == 0) ? v0 : ((jb == 1) ? v1 : true);
                        if (ok) {
#pragma unroll
                            for (int sb = 0; sb < 2; ++sb) {
                                const bf16x8 vf = *(const LAS bf16x8*)(L + KBYTES + (16 * dt + i16) * VP + (64 * jb + 32 * sb + 8 * g4) * 2);
                                oc = __builtin_amdgcn_mfma_f32_16x16x32_bf16(vf, pf[2 * jb + sb], oc, 0, 0, 0); }
                        }
                    }
                    *(v2u*)(HG + ooff + 16 * dt) = (v2u){pk2(oc[0] * bflo(gw2[dt].x), oc[1] * bfhi(gw2[dt].x)), pk2(oc[2] * bflo(gw2[dt].y), oc[3] * bfhi(gw2[dt].y))};
                }
                __builtin_amdgcn_sched_barrier(0);
            }
            buf ^= 1;
        }
#undef ATT_DESC
#undef ATT_LOAD
        __syncthreads();
    }
    SEAM(8);

    if (IN(9)) for (int rep_ = 0; rep_ < REPS(9); ++rep_) {
        pg8::Gemm g{HG, WT_OUTB, M, 1024, 1024, 1024, 1024, 0, 0}; pg8::StaticOrder S; S.init(M, 1024, G, bid);
        EpiOutB E{out + O_Y};
        pg8::gemm_phase<EpiOutB, pg8::StaticOrder, true>(lds, g, S, E);
    }
#undef IN
#undef SEAM
}

extern "C" void kernel_launch(void* const* d_in, const int* in_sizes, int n_in, void* d_out, int out_size, void* d_ws, size_t ws_size, hipStream_t stream) {
    static int grid = 0;
    if (grid == 0) {
        if (n_in != 24 || ws_size < WS_END) { fprintf(stderr, "kernel_launch: unexpected n_in %d / ws %zu\n", n_in, ws_size); grid = -1; return; }
        int dev = 0, cus = 0, per_cu = 0;
        (void)hipGetDevice(&dev);
        (void)hipDeviceGetAttribute(&cus, hipDeviceAttributeMultiprocessorCount, dev);
        if (hipFuncSetAttribute((const void*)yoco_fwd, hipFuncAttributeMaxDynamicSharedMemorySize, LDS_BYTES) != hipSuccess) { fprintf(stderr, "kernel_launch: hipFuncSetAttribute failed\n"); }
        if (hipOccupancyMaxActiveBlocksPerMultiprocessor(&per_cu, (const void*)yoco_fwd, 512, LDS_BYTES) != hipSuccess || per_cu < 1) { fprintf(stderr, "kernel_launch: occupancy query gave %d\n", per_cu); per_cu = 1; }
        (void)hipGetLastError();
        if (per_cu > 1) per_cu = 1;
        grid = cus * per_cu;
    }
    if (grid < 0) return;
    Args a{};
    for (int i = 0; i < 24; ++i) a.in[i] = (const float*)d_in[i];
    a.out = (float*)d_out; a.ws = (unsigned char*)d_ws;
#if MK_SINGLE
    if (hipMemsetAsync(d_ws, 0, 16384, stream) != hipSuccess) { fprintf(stderr, "kernel_launch: memset of the barrier words failed\n"); return; }
    a.ph_lo = 0; a.ph_hi = NPH;
    void* kargs[] = {&a};
    hipError_t e = hipLaunchCooperativeKernel((const void*)yoco_fwd, dim3(grid), dim3(512), kargs, LDS_BYTES, stream);
    if (e != hipSuccess) fprintf(stderr, "cooperative launch failed: %s (grid %d)\n", hipGetErrorString(e), grid);
#else
    for (int ph = 0; ph < NPH; ++ph) {
        a.ph_lo = ph; a.ph_hi = ph + 1;
        hipLaunchKernelGGL(yoco_fwd, dim3(grid), dim3(512), LDS_BYTES, stream, a);
    }
#endif
}
```

```cpp
#include <hip/hip_runtime.h>
#include <hip/hip_cooperative_groups.h>
#include <cstdio>
#include <cstdint>
namespace cg = cooperative_groups;

#ifndef MK_SINGLE
#define MK_SINGLE 1
#endif
#ifndef PROBE_MASK
#define PROBE_MASK 0
#endif
#define REPS(k) (((PROBE_MASK >> (k)) & 1) ? 3 : 1)

namespace pg8 {
#define PG8_LAS __attribute__((address_space(3)))
typedef unsigned short bf16_t;
typedef short bf16x8 __attribute__((ext_vector_type(8)));
typedef float f32x4 __attribute__((ext_vector_type(4)));
typedef unsigned u32x4 __attribute__((ext_vector_type(4)));
constexpr int BM = 256, BK = 64, HALF = 128, HTB = HALF * BK * 2  , STAGE_BYTES = 8 * HTB, NXCD = 8, WGM = 8;

__host__ __device__ __forceinline__ int lds_byte(int r, int c) { const int st = (r >> 4) * 2 + (c >> 5), rr = r & 15, cc = c & 31, ob = rr * 64 + cc * 2; return st * 1024 + (ob ^ (((ob >> 9) & 1) << 5)); }
__host__ __device__ __forceinline__ void stage_rc(int b, int& R, int& C) { const int st = b / 1024, sb = b % 1024, swz = sb ^ (((sb >> 9) & 1) << 5); R = (st >> 1) * 16 + swz / 64; C = (st & 1) * 32 + (swz % 64) / 2; }
__host__ __device__ __forceinline__ int perm32(int rho) { const int n = rho >> 4, i = rho & 15; return 8 * (i >> 2) + 4 * n + (i & 3); }

struct Unit { int pm, pn; };
struct Gemm { const bf16_t* A; const bf16_t* Bt; int M, N, K, lda, ldb, apn_shift, apn_elems; };

struct StaticOrder {
    int nM, nN, nwg, G, c;
    __host__ __device__ void init(int M, int N, int G_, int c_) { nM = M / BM; nN = N / BM; nwg = nM * nN; G = G_; c = c_; }
    __host__ __device__ bool next(int i, Unit& u) const {
        const long L = (long)i * G + c; if (L >= nwg) return false;
        int wgid = (int)L; { const int q = nwg / NXCD, r = nwg % NXCD, xcd = wgid % NXCD, off = wgid / NXCD; wgid = (xcd < r ? xcd * (q + 1) : r * (q + 1) + (xcd - r) * q) + off; }
        const int nig = WGM * nN, gid = wgid / nig, fm = gid * WGM, gsz = (nM - fm) < WGM ? (nM - fm) : WGM;
        u.pm = fm + ((wgid % nig) % gsz); u.pn = (wgid % nig) / gsz; return true;
    }
};

__device__ __forceinline__ unsigned cvt_pk_bf16(float lo, float hi) { unsigned r; asm volatile("v_cvt_pk_bf16_f32 %0, %1, %2" : "=v"(r) : "v"(lo), "v"(hi)); return r; }

template <class Epi, class Sched, bool ALIGN_EPI, bool ROWPERM = false>
__device__ __forceinline__ void gemm_phase(PG8_LAS unsigned char* lds, const Gemm g, const Sched& S, const Epi& E) {
    const int tid = threadIdx.x, wid = __builtin_amdgcn_readfirstlane(tid >> 6), lane = tid & 63, wr = wid >> 2, wc = wid & 3, fr = lane & 15, fq = lane >> 4;
    const int K = g.K, nt = K / BK;
    unsigned voffA[2], voffB[2];
#pragma unroll
    for (int i = 0; i < 2; ++i) { int R, C; stage_rc(tid * 16 + i * 8192, R, C); const int Rb = Epi::PERM ? ((R & ~31) + perm32(R & 31)) : R;
        const int Ra = ROWPERM ? ((R & 64) + 4 * (R & 15) + ((R >> 4) & 3)) : R;
        voffA[i] = (unsigned)(Ra * g.lda + C) * 2u; voffB[i] = (unsigned)(Rb * g.ldb + C) * 2u; }
    const size_t kstep = (size_t)(BK * 2);
    const size_t hstepA = (size_t)HALF * g.lda * 2, hstepB = (size_t)HALF * g.ldb * 2;
    const size_t tstepA = 2 * hstepA, tstepB = 2 * hstepB;
    const unsigned ldsw = (unsigned)wid * 1024u;
    const int aoff = lds_byte(wr * 64 + fr, fq * 8), boff = lds_byte(wc * 32 + fr, fq * 8);
#define PG8_SA(b, h) (((b) * 2 + (h)) * HTB)
#define PG8_SB(b, h) ((4 + (b) * 2 + (h)) * HTB)
#define PG8_STAGE(bufoff, gbase, voff) do { _Pragma("unroll") for (int _i = 0; _i < 2; ++_i) \
        __builtin_amdgcn_global_load_lds((const unsigned*)((const char*)(gbase) + (voff)[_i]), (PG8_LAS unsigned*)(lds + (bufoff) + ldsw + _i * 8192), 16, 0, 0); } while (0)
#define PG8_LDA(dst, b, h) do { _Pragma("unroll") for (int m = 0; m < 4; ++m) _Pragma("unroll") for (int k = 0; k < 2; ++k) dst[m][k] = *(const PG8_LAS bf16x8*)(lds + PG8_SA(b, h) + aoff + m * 2048 + k * 1024); } while (0)
#define PG8_LDB(dst, b, h) do { _Pragma("unroll") for (int n = 0; n < 2; ++n) _Pragma("unroll") for (int k = 0; k < 2; ++k) dst[n][k] = *(const PG8_LAS bf16x8*)(lds + PG8_SB(b, h) + boff + n * 2048 + k * 1024); } while (0)
#define PG8_MMA(ai, bj, At, Bt) do { __builtin_amdgcn_s_setprio(1); _Pragma("unroll") for (int m = 0; m < 4; ++m) _Pragma("unroll") for (int n = 0; n < 2; ++n) _Pragma("unroll") for (int k = 0; k < 2; ++k) \
        acc[ai][bj][m][n] = __builtin_amdgcn_mfma_f32_16x16x32_bf16(Bt[n][k], At[m][k], acc[ai][bj][m][n], 0, 0, 0); __builtin_amdgcn_s_setprio(0); } while (0)
#define PG8_WAIT_V(n) asm volatile("s_waitcnt vmcnt(" #n ")" ::: "memory")
#define PG8_WAIT_L(n) asm volatile("s_waitcnt lgkmcnt(" #n ")" ::: "memory")
#define PG8_BAR __builtin_amdgcn_s_barrier()
#define PG8_SCHED __builtin_amdgcn_sched_barrier(0)
#define PG8_AOFF(u) ((size_t)(((u).pn >> g.apn_shift) * g.apn_elems) * 2)
    Unit cur, nxt; int ui = 0;
    if (!S.next(0, cur)) return;
    f32x4 acc[2][2][4][2];
#pragma unroll
    for (int a = 0; a < 2; ++a)
#pragma unroll
        for (int b = 0; b < 2; ++b)
#pragma unroll
            for (int m = 0; m < 4; ++m)
#pragma unroll
                for (int n = 0; n < 2; ++n) acc[a][b][m][n] = (f32x4){0.f, 0.f, 0.f, 0.f};
    bf16x8 At[4][2], B0[2][2], B1[2][2];
    const char* cA = (const char*)g.A + (size_t)cur.pm * tstepA + PG8_AOFF(cur); const char* cB = (const char*)g.Bt + (size_t)cur.pn * tstepB;
    PG8_STAGE(PG8_SB(0, 0), cB, voffB); PG8_STAGE(PG8_SB(0, 1), cB + hstepB, voffB); PG8_STAGE(PG8_SA(0, 0), cA, voffA); PG8_STAGE(PG8_SA(0, 1), cA + hstepA, voffA);
    if (wr == 1) PG8_BAR;
    PG8_WAIT_V(2); PG8_BAR;
    PG8_STAGE(PG8_SB(1, 0), cB + kstep, voffB); PG8_STAGE(PG8_SA(1, 0), cA + kstep, voffA); PG8_STAGE(PG8_SB(1, 1), cB + hstepB + kstep, voffB);
    PG8_WAIT_V(6); PG8_BAR;
    for (;;) {
        const bool has_next = S.next(ui + 1, nxt);
        const char* nA = has_next ? (const char*)g.A + (size_t)nxt.pm * tstepA + PG8_AOFF(nxt) : cA; const char* nB = has_next ? (const char*)g.Bt + (size_t)nxt.pn * tstepB : cB;
        for (int t = 0; t < nt; t += 2) {
            const bool last = (t == nt - 2);
            const char* a1 = cA + (size_t)(t + 1) * kstep;
            const char* a2 = last ? nA : cA + (size_t)(t + 2) * kstep; const char* b2 = last ? nB : cB + (size_t)(t + 2) * kstep;
            const char* a3 = a2 + kstep; const char* b3 = b2 + kstep;
            PG8_LDB(B0, 0, 0); PG8_LDB(B1, 0, 1); PG8_SCHED; PG8_LDA(At, 0, 0); PG8_STAGE(PG8_SA(1, 1), a1 + hstepA, voffA);
            PG8_WAIT_V(8); PG8_WAIT_L(0); PG8_BAR; PG8_MMA(0, 0, At, B0); PG8_MMA(0, 1, At, B1); PG8_BAR; PG8_SCHED;
            PG8_LDA(At, 0, 1); PG8_STAGE(PG8_SB(0, 0), b2, voffB); PG8_STAGE(PG8_SB(0, 1), b2 + hstepB, voffB); PG8_STAGE(PG8_SA(0, 0), a2, voffA);
            PG8_WAIT_V(8); PG8_WAIT_L(0); PG8_BAR; PG8_MMA(1, 0, At, B0); PG8_MMA(1, 1, At, B1); PG8_BAR; PG8_SCHED;
            PG8_LDB(B0, 1, 0); PG8_LDB(B1, 1, 1); PG8_SCHED; PG8_LDA(At, 1, 0); PG8_STAGE(PG8_SA(0, 1), a2 + hstepA, voffA);
            PG8_WAIT_V(8); PG8_WAIT_L(0); PG8_BAR; PG8_MMA(0, 0, At, B0); PG8_MMA(0, 1, At, B1); PG8_BAR; PG8_SCHED;
            PG8_LDA(At, 1, 1); PG8_STAGE(PG8_SB(1, 0), b3, voffB); PG8_STAGE(PG8_SB(1, 1), b3 + hstepB, voffB); PG8_STAGE(PG8_SA(1, 0), a3, voffA);
            PG8_WAIT_V(8); PG8_WAIT_L(0); PG8_BAR; PG8_MMA(1, 0, At, B0); PG8_MMA(1, 1, At, B1); PG8_BAR; PG8_SCHED;
        }
        if constexpr (ALIGN_EPI) { if (wr == 0) PG8_BAR; }
        E(acc, cur, wr, wc, fr, fq);
        if (!has_next) break;
#pragma unroll
        for (int a = 0; a < 2; ++a)
#pragma unroll
            for (int b = 0; b < 2; ++b)
#pragma unroll
                for (int m = 0; m < 4; ++m)
#pragma unroll
                    for (int n = 0; n < 2; ++n) acc[a][b][m][n] = (f32x4){0.f, 0.f, 0.f, 0.f};
        cur = nxt; cA = nA; cB = nB; ++ui;
        if constexpr (ALIGN_EPI) { if (wr == 1) PG8_BAR; }
    }
    PG8_WAIT_V(0);
    if constexpr (!ALIGN_EPI) { if (wr == 0) PG8_BAR; }
    PG8_BAR;
#undef PG8_SA
#undef PG8_SB
#undef PG8_STAGE
#undef PG8_LDA
#undef PG8_LDB
#undef PG8_MMA
#undef PG8_WAIT_V
#undef PG8_WAIT_L
#undef PG8_BAR
#undef PG8_SCHED
#undef PG8_AOFF
}
}

#define LAS __attribute__((address_space(3)))
typedef unsigned short bf16_t;
typedef unsigned v4u __attribute__((ext_vector_type(4)));
typedef unsigned v2u __attribute__((ext_vector_type(2)));
typedef float f32x4 __attribute__((ext_vector_type(4)));
typedef short bf16x8 __attribute__((ext_vector_type(8)));

constexpr int D = 1024, TP = 2048, TS = 64, NBP = 16, NBS = 32;
constexpr int MP = NBP * TP;
constexpr int MS = NBS * TS;
constexpr int M = MP + MS;
constexpr float EPS = 1e-6f;
constexpr size_t O_Y = 0, O_CONVP = 35651584, O_HP = 35700736, O_KP = 35717120, O_VP = 35979264, O_CONVS = 36241408, O_HS = 36339712, O_KS = 36372480, O_VS = 36896768;
constexpr size_t MiB = 1u << 20;
constexpr size_t WS_WINA = 1 * MiB, WS_WGATE = 5 * MiB, WS_WOUTA = 6 * MiB, WS_WB = 8 * MiB, WS_WOUTB = 13 * MiB, WS_SS = 15 * MiB, WS_CP = 16 * MiB, WS_CH = 19 * MiB,
                 WS_KC = 22 * MiB, WS_VTC = 23 * MiB, WS_VTS = 24 * MiB, WS_KB = 25 * MiB, WS_VTP = 34 * MiB, WS_R1 = 48 * MiB, WS_R2 = 116 * MiB, WS_R3 = 252 * MiB, WS_END = 388 * MiB;
constexpr int LDS_BYTES = 135168;
constexpr int NPH = 10;

__device__ __forceinline__ unsigned pk2(float lo, float hi) { return pg8::cvt_pk_bf16(lo, hi); }
__device__ __forceinline__ float bflo(unsigned w) { return __uint_as_float(w << 16); }
__device__ __forceinline__ float bfhi(unsigned w) { return __uint_as_float(w & 0xffff0000u); }
__device__ __forceinline__ float bf2f(bf16_t b) { return __uint_as_float((unsigned)b << 16); }
__device__ __forceinline__ float sigmoidf_(float x) { return __builtin_amdgcn_rcpf(1.0f + __expf(-x)); }
__device__ __forceinline__ float wave_sum(float v) {
#pragma unroll
    for (int o = 1; o < 64; o <<= 1) v += __shfl_xor(v, o);
    return v;
}

using pg8::Unit;
struct EpiStore {
    static constexpr bool PERM = true;
    bf16_t* O; int ldc;
    __device__ __forceinline__ void operator()(const f32x4 (&acc)[2][2][4][2], const Unit& u, int wr, int wc, int fr_, int fq_) const {
        int fr = fr_, fq = fq_; asm volatile("" : "+v"(fr), "+v"(fq));
        const int row0 = u.pm * 256 + wr * 64 + fr, col0 = u.pn * 256 + wc * 32 + 8 * fq;
#pragma unroll
        for (int ai = 0; ai < 2; ++ai)
#pragma unroll
            for (int m = 0; m < 4; ++m) { bf16_t* rowp = O + (size_t)(row0 + ai * 128 + m * 16) * ldc + col0;
#pragma unroll
                for (int bj = 0; bj < 2; ++bj) { const f32x4 v0 = acc[ai][bj][m][0], v1 = acc[ai][bj][m][1];
                    v4u w; w.x = pk2(v0[0], v0[1]); w.y = pk2(v0[2], v0[3]); w.z = pk2(v1[0], v1[1]); w.w = pk2(v1[2], v1[3]);
                    *(v4u*)(rowp + bj * 128) = w; } }
    }
};
struct EpiGate {
    static constexpr bool PERM = true;
    const bf16_t* XC; const float* bgx; const float* bga; const float* lam; unsigned* AB; float* CP; float* CH;
    __device__ __forceinline__ void operator()(const f32x4 (&acc)[2][2][4][2], const Unit& u, int wr, int wc, int fr_, int fq_) const {
        int fr = fr_, fq = fq_; asm volatile("" : "+v"(fr), "+v"(fq));
        const int ch0 = u.pn * 128 + wc * 32 + 8 * fq;
#pragma unroll
        for (int ai = 0; ai < 2; ++ai) {
            const int rbase = u.pm * 256 + ai * 128 + wr * 64;
            float PA[8], PB[8];
#pragma unroll
            for (int m = 0; m < 4; ++m) { const size_t off = (size_t)(rbase + 4 * fr + m) * D + ch0;
                asm volatile("" ::: "memory");
                const v4u xw = *(const v4u*)(XC + off);
                float xc[8] = {bflo(xw.x), bfhi(xw.x), bflo(xw.y), bfhi(xw.y), bflo(xw.z), bfhi(xw.z), bflo(xw.w), bfhi(xw.w)};
#pragma unroll
                for (int n = 0; n < 2; ++n) { const f32x4 t0 = *(const f32x4*)(bgx + ch0 + 4 * n), t1 = *(const f32x4*)(bga + ch0 + 4 * n), t2 = *(const f32x4*)(lam + ch0 + 4 * n);
                    unsigned ow[4];
#pragma unroll
                    for (int e = 0; e < 4; ++e) {
                        const float ig = sigmoidf_(acc[ai][0][m][n][e] + t0[e]);
                        const float rg = sigmoidf_(acc[ai][1][m][n][e] + t1[e]);
                        const float la = t2[e] * rg;
                        const float a = __expf(la);
                        const float mult = sqrtf(fmaxf(1.0f - a * a, 0.f));
                        const float bxv = mult * ig * xc[4 * n + e];
                        const _Float16 lh = (_Float16)la;
                        const unsigned bw = pk2(bxv, bxv) & 0xffff0000u;
                        ow[e] = (unsigned)__builtin_bit_cast(unsigned short, lh) | bw;
                        const float ar = __expf((float)lh), br = __uint_as_float(bw);
                        if (m == 0) { PA[4 * n + e] = ar; PB[4 * n + e] = br; } else { PA[4 * n + e] *= ar; PB[4 * n + e] = ar * PB[4 * n + e] + br; } }
                    *(v4u*)(AB + off + 4 * n) = (v4u){ow[0], ow[1], ow[2], ow[3]};
                    __builtin_amdgcn_sched_barrier(0); } }
#pragma unroll
            for (int sft = 1; sft < 16; sft <<= 1) { const bool hi = (fr & sft) != 0;
#pragma unroll
                for (int j = 0; j < 8; ++j) { const float pa = __shfl_xor(PA[j], sft), pb = __shfl_xor(PB[j], sft);
                    PB[j] = hi ? (PA[j] * pb + PB[j]) : (pa * PB[j] + pb); PA[j] *= pa; } }
            if (fr == 0) { const size_t co = (size_t)(rbase >> 6) * D + ch0;
                *(f32x4*)(CP + co) = (f32x4){PA[0], PA[1], PA[2], PA[3]}; *(f32x4*)(CP + co + 4) = (f32x4){PA[4], PA[5], PA[6], PA[7]};
                *(f32x4*)(CH + co) = (f32x4){PB[0], PB[1], PB[2], PB[3]}; *(f32x4*)(CH + co + 4) = (f32x4){PB[4], PB[5], PB[6], PB[7]}; }
        }
    }
};
struct EpiOutA {
    static constexpr bool PERM = true;
    const float* xp; const float* xs; bf16_t* X1B; float* SS;
    __device__ __forceinline__ void operator()(const f32x4 (&acc)[2][2][4][2], const Unit& u, int wr, int wc, int fr_, int fq_) const {
        int fr = fr_, fq = fq_; asm volatile("" : "+v"(fr), "+v"(fq));
        const int row0 = u.pm * 256 + wr * 64 + fr, col0 = u.pn * 256 + wc * 32 + 8 * fq;
#pragma unroll
        for (int ai = 0; ai < 2; ++ai)
#pragma unroll
            for (int m = 0; m < 4; ++m) { const int row = row0 + ai * 128 + m * 16;
                asm volatile("" ::: "memory");
                const float* xr = (row < MP) ? xp + (size_t)row * D : xs + (size_t)(row - MP) * D;
                float ssq = 0.f;
#pragma unroll
                for (int bj = 0; bj < 2; ++bj) { const int c = col0 + bj * 128;
                    const f32x4 v0 = acc[ai][bj][m][0] + *(const f32x4*)(xr + c), v1 = acc[ai][bj][m][1] + *(const f32x4*)(xr + c + 4);
                    v4u w; w.x = pk2(v0[0], v0[1]); w.y = pk2(v0[2], v0[3]); w.z = pk2(v1[0], v1[1]); w.w = pk2(v1[2], v1[3]);
                    *(v4u*)(X1B + (size_t)row * D + c) = w;
                    ssq += (v0[0] * v0[0] + v0[1] * v0[1]) + (v0[2] * v0[2] + v0[3] * v0[3]) + (v1[0] * v1[0] + v1[1] * v1[1]) + (v1[2] * v1[2] + v1[3] * v1[3]); }
                ssq += __shfl_xor(ssq, 16); ssq += __shfl_xor(ssq, 32);
                if (fq == 0) atomicAdd(SS + row, ssq); }
    }
};
struct EpiB {
    static constexpr bool PERM = true;
    const float* SS; const float* qg; const float* kg; bf16_t* QB; bf16_t* GB; bf16_t* KB; bf16_t* VTP; bf16_t* VTS; float* out;
    __device__ __forceinline__ void operator()(const f32x4 (&acc)[2][2][4][2], const Unit& u, int wr, int wc, int fr_, int fq_) const {
        int fr = fr_, fq = fq_; asm volatile("" : "+v"(fr), "+v"(fq));
        const int Hd = 4 * u.pn + wc, row0 = u.pm * 256 + wr * 64 + fr;
        const bool normed = (Hd < 16) || (Hd == 32) || (Hd == 33);
        const float* gsrc = (Hd < 16) ? qg : kg; const float gscale = (Hd < 16) ? 0.125f : 1.0f;
#pragma unroll
        for (int ai = 0; ai < 2; ++ai)
#pragma unroll
            for (int m = 0; m < 4; ++m) { const int row = row0 + ai * 128 + m * 16;
                asm volatile("" ::: "memory");
                const float rs = rsqrtf(SS[row] * (1.0f / D) + EPS);
                float v[2][8];
#pragma unroll
                for (int bj = 0; bj < 2; ++bj)
#pragma unroll
                    for (int n = 0; n < 2; ++n)
#pragma unroll
                        for (int e = 0; e < 4; ++e) v[bj][4 * n + e] = acc[ai][bj][m][n][e] * rs;
                if (normed) {
                    float ssq = 0.f;
#pragma unroll
                    for (int bj = 0; bj < 2; ++bj)
#pragma unroll
                        for (int e = 0; e < 8; ++e) ssq += v[bj][e] * v[bj][e];
                    ssq += __shfl_xor(ssq, 16); ssq += __shfl_xor(ssq, 32);
                    const float hn = rsqrtf(ssq * (1.0f / 64.0f) + EPS) * gscale;
#pragma unroll
                    for (int bj = 0; bj < 2; ++bj) { const f32x4 g0 = *(const f32x4*)(gsrc + 32 * bj + 8 * fq), g1 = *(const f32x4*)(gsrc + 32 * bj + 8 * fq + 4);
#pragma unroll
                        for (int e = 0; e < 4; ++e) { v[bj][e] *= hn * g0[e]; v[bj][4 + e] *= hn * g1[e]; } }
                }
                if (Hd < 32) {
                    if (Hd >= 16) {
#pragma unroll
                        for (int bj = 0; bj < 2; ++bj)
#pragma unroll
                            for (int e = 0; e < 8; ++e) v[bj][e] = v[bj][e] * sigmoidf_(v[bj][e]);
                    }
                    bf16_t* dst = ((Hd < 16) ? QB : GB) + (size_t)row * D + (Hd & 15) * 64 + 8 * fq;
#pragma unroll
                    for (int bj = 0; bj < 2; ++bj) { v4u w; w.x = pk2(v[bj][0], v[bj][1]); w.y = pk2(v[bj][2], v[bj][3]); w.z = pk2(v[bj][4], v[bj][5]); w.w = pk2(v[bj][6], v[bj][7]);
                        *(v4u*)(dst + 32 * bj) = w; }
                } else {
                    const int h = Hd & 1; const bool isv = Hd >= 34;
                    float* od = nullptr; int sq, t;
                    if (row < MP) { sq = row >> 11; t = row & 2047; if (t >= TP - 128) od = out + (isv ? O_VP : O_KP) + ((size_t)(sq * 128 + (t - (TP - 128))) * 2 + h) * 64; }
                    else { sq = (row - MP) >> 6; t = (row - MP) & 63; od = out + (isv ? O_VS : O_KS) + ((size_t)(sq * 128 + 64 + t) * 2 + h) * 64; }
                    if (od) {
#pragma unroll
                        for (int bj = 0; bj < 2; ++bj) { float* p = od + 32 * bj + 8 * fq;
                            *(f32x4*)p = (f32x4){v[bj][0], v[bj][1], v[bj][2], v[bj][3]}; *(f32x4*)(p + 4) = (f32x4){v[bj][4], v[bj][5], v[bj][6], v[bj][7]}; }
                    }
                    if (!isv) {
                        bf16_t* dst = KB + (size_t)row * 128 + h * 64 + 8 * fq;
#pragma unroll
                        for (int bj = 0; bj < 2; ++bj) { v4u w; w.x = pk2(v[bj][0], v[bj][1]); w.y = pk2(v[bj][2], v[bj][3]); w.z = pk2(v[bj][4], v[bj][5]); w.w = pk2(v[bj][6], v[bj][7]);
                            *(v4u*)(dst + 32 * bj) = w; }
                    } else {
                        bf16_t* vb; int pitch;
                        if (row < MP) { vb = VTP + (size_t)((sq * 2 + h) * 64) * TP + t; pitch = TP; } else { vb = VTS + (size_t)((sq * 2 + h) * 64) * TS + t; pitch = TS; }
#pragma unroll
                        for (int bj = 0; bj < 2; ++bj)
#pragma unroll
                            for (int e = 0; e < 8; ++e) vb[(size_t)(32 * bj + 8 * fq + e) * pitch] = (bf16_t)(pk2(v[bj][e], v[bj][e]) & 0xffffu);
                    }
                }
            }
    }
};
struct EpiOutB {
    static constexpr bool PERM = true;
    const bf16_t* X1B; float* Y;
    __device__ __forceinline__ void operator()(const f32x4 (&acc)[2][2][4][2], const Unit& u, int wr, int wc, int fr_, int fq_) const {
        int fr = fr_, fq = fq_; asm volatile("" : "+v"(fr), "+v"(fq));
        const int row0 = u.pm * 256 + wr * 64 + fr, col0 = u.pn * 256 + wc * 32 + 8 * fq;
#pragma unroll
        for (int ai = 0; ai < 2; ++ai)
#pragma unroll
            for (int m = 0; m < 4; ++m) { const size_t ro = (size_t)(row0 + ai * 128 + m * 16) * D + col0;
                asm volatile("" ::: "memory");
#pragma unroll
                for (int bj = 0; bj < 2; ++bj) { const v4u xw = *(const v4u*)(X1B + ro + bj * 128); float* p = Y + ro + bj * 128;
                    const f32x4 v0 = acc[ai][bj][m][0] + (f32x4){bflo(xw.x), bfhi(xw.x), bflo(xw.y), bfhi(xw.y)}, v1 = acc[ai][bj][m][1] + (f32x4){bflo(xw.z), bfhi(xw.z), bflo(xw.w), bfhi(xw.w)};
                    *(f32x4*)p = v0; *(f32x4*)(p + 4) = v1; } }
    }
};

struct RmId { __device__ __forceinline__ int operator()(int n) const { return n; } };
struct RmGate { int g, isA; __device__ __forceinline__ int operator()(int n) const { return 256 * (2 * g + (n >> 7)) + (n & 127) + (isA ? 128 : 0); } };
struct RmHead { int head0; __device__ __forceinline__ int operator()(int n) const { const int H = head0 + (n >> 6), j = n & 63; return 256 * (H >> 2) + 128 * (j >> 5) + 32 * (H & 3) + (j & 31); } };
template <class RM>
__device__ __forceinline__ void transpose_item(const float* W, int ldw, int nblk, const float* gain, bf16_t* WT, int ldt, const RM rm, LAS float* scr, int item, int lane) {
    const int kb = item / nblk, nb = item % nblk, k0 = 64 * kb, n0 = 32 * nb;
#pragma unroll 8
    for (int i = 0; i < 32; ++i) { const int kk = 2 * i + (lane >> 5); const float gsc = gain ? gain[k0 + kk] : 1.0f; scr[kk * 33 + (lane & 31)] = W[(size_t)(k0 + kk) * ldw + n0 + (lane & 31)] * gsc; }
    asm volatile("s_waitcnt lgkmcnt(0)" ::: "memory");
    const int c = lane & 7;
#pragma unroll
    for (int j = 0; j < 4; ++j) { const int n = (lane >> 3) + 8 * j; const LAS float* s = scr + (8 * c) * 33 + n;
        v4u o; o.x = pk2(s[0 * 33], s[1 * 33]); o.y = pk2(s[2 * 33], s[3 * 33]); o.z = pk2(s[4 * 33], s[5 * 33]); o.w = pk2(s[6 * 33], s[7 * 33]);
        *(v4u*)(WT + (size_t)rm(n0 + n) * ldt + k0 + 8 * c) = o; }
    asm volatile("s_waitcnt lgkmcnt(0)" ::: "memory");
}


#define XB_TMO      128
#define XB_XCNT(j)  (256  + 64 * (j))
#define XB_XSUB(j)  (1280 + 64 * (j))
#define XB_XGEN(j)  (2304 + 64 * (j))
#define XB_TOP      3328
#define XB_TOPGEN   3392
#define XCD_BAR_WORDS 3456
#define XB_SPIN_CAP (1u << 22)
__device__ __forceinline__ unsigned xb_ld(unsigned* p)              { return __hip_atomic_load(p, __ATOMIC_RELAXED, __HIP_MEMORY_SCOPE_AGENT); }
__device__ __forceinline__ unsigned xb_add(unsigned* p, unsigned v) { return __hip_atomic_fetch_add(p, v, __ATOMIC_RELAXED, __HIP_MEMORY_SCOPE_AGENT); }
__device__ __forceinline__ unsigned xb_xcc_id() { return (unsigned)__builtin_amdgcn_s_getreg((3 << 11) | 20) & 0xFu; }
#define XB_SPIN(cond, bar) do { unsigned _sp = 0; while (cond) { __builtin_amdgcn_s_sleep(1); \
    if ((++_sp & 255u) == 0u) { if (xb_ld(&(bar)[XB_TMO])) break; if (_sp > XB_SPIN_CAP) { atomicAdd(&(bar)[XB_TMO], 1u); break; } } } } while (0)
struct XcdBarrier { unsigned* bar; unsigned x; volatile LAS unsigned* st; };
__device__ __forceinline__ XcdBarrier xcd_barrier_post(unsigned* bar, volatile LAS unsigned* st) {
    XcdBarrier b; b.bar = bar; b.x = xb_xcc_id(); b.st = st;
    if (threadIdx.x == 0) (void)xb_add(&bar[XB_XCNT(b.x)], 1u);
    return b;
}
__device__ __forceinline__ void xcd_barrier_complete(unsigned* bar, unsigned x, unsigned& nloc, unsigned& nx) {
    const unsigned G = gridDim.x * gridDim.y * gridDim.z;
    unsigned sum, cnt, mine, sp = 0u;
    for (;;) {
        sum = 0u; cnt = 0u; mine = 0u;
#pragma unroll
        for (unsigned j = 0; j < 16; ++j) { const unsigned c = xb_ld(&bar[XB_XCNT(j)]); sum += c; cnt += (c > 0u) ? 1u : 0u; mine = (j == x) ? c : mine; }
        if (sum == G) break;
        __builtin_amdgcn_s_sleep(1);
        if ((++sp & 255u) == 0u) { if (xb_ld(&bar[XB_TMO])) break; if (sp > XB_SPIN_CAP) { atomicAdd(&bar[XB_TMO], 1u); break; } }
    }
    nloc = mine > 0u ? mine : 1u; nx = cnt > 0u ? cnt : 1u;
}
__device__ __forceinline__ void xcd_barrier(const XcdBarrier& b) {
    asm volatile("s_waitcnt vmcnt(0)" ::: "memory");
    __syncthreads();
    if (threadIdx.x == 0) {
        unsigned* bar = b.bar;
        __builtin_amdgcn_s_waitcnt(0);
        unsigned nloc = b.st[0], nx = b.st[1];
        if (nloc == 0u) { xcd_barrier_complete(bar, b.x, nloc, nx); b.st[0] = nloc; b.st[1] = nx; }
        const unsigned old = xb_add(&bar[XB_XSUB(b.x)], 1u);
        const unsigned gen = old / nloc;
        if (old + 1u == (gen + 1u) * nloc) {
            __builtin_amdgcn_fence(__ATOMIC_RELEASE, "agent");
            asm volatile("s_waitcnt vmcnt(0)" ::: "memory");
            const unsigned og = xb_add(&bar[XB_TOP], 1u);
            const unsigned tg = og / nx;
            if (og + 1u == (tg + 1u) * nx) xb_add(&bar[XB_TOPGEN], 1u);
            else XB_SPIN(xb_ld(&bar[XB_TOPGEN]) == tg, bar);
            __builtin_amdgcn_fence(__ATOMIC_ACQUIRE, "agent");
            xb_add(&bar[XB_XGEN(b.x)], 1u);
            asm volatile("s_waitcnt vmcnt(0)" ::: "memory");
        } else {
            XB_SPIN(xb_ld(&bar[XB_XGEN(b.x)]) == gen, bar);
            __builtin_amdgcn_fence(__ATOMIC_ACQUIRE, "agent");
            asm volatile("s_waitcnt vmcnt(0)" ::: "memory");
        }
    }
    __syncthreads();
}

struct Args { const float* in[24]; float* out; unsigned char* ws; int ph_lo, ph_hi; };

__global__ void __launch_bounds__(512, 2) yoco_fwd(Args args) {
    extern __shared__ __attribute__((aligned(16))) unsigned char lds_raw[];
    LAS unsigned char* lds = (LAS unsigned char*)lds_raw;
    const int tid = threadIdx.x, lane = tid & 63, wave = __builtin_amdgcn_readfirstlane(tid >> 6);
    const int G = gridDim.x, bid = blockIdx.x;
    const int gw = bid * 8 + wave, NGW = G * 8;
    const int gtid = bid * 512 + tid, NT = G * 512;
    unsigned char* ws = args.ws; float* out = args.out;
typedef const float* cfp_t;
#define ARGP(k) (((cfp_t const volatile __attribute__((address_space(4)))*)__builtin_amdgcn_kernarg_segment_ptr())[k])
    bf16_t* WT_INA = (bf16_t*)(ws + WS_WINA); bf16_t* WT_GATE = (bf16_t*)(ws + WS_WGATE); bf16_t* WT_OUTA = (bf16_t*)(ws + WS_WOUTA);
    bf16_t* WT_B = (bf16_t*)(ws + WS_WB); bf16_t* WT_OUTB = (bf16_t*)(ws + WS_WOUTB);
    float* SS = (float*)(ws + WS_SS); float* CL = (float*)(ws + WS_SS + 512 * 1024); float* CP = (float*)(ws + WS_CP); float* CH = (float*)(ws + WS_CH);
    bf16_t* KC = (bf16_t*)(ws + WS_KC); bf16_t* VTC = (bf16_t*)(ws + WS_VTC); bf16_t* VTS = (bf16_t*)(ws + WS_VTS);
    bf16_t* KB = (bf16_t*)(ws + WS_KB); bf16_t* VTP = (bf16_t*)(ws + WS_VTP);
    bf16_t* XN = (bf16_t*)(ws + WS_R1); bf16_t* XC = XN; bf16_t* HG = XN;
    bf16_t* U = (bf16_t*)(ws + WS_R2); bf16_t* X1B = U;
    unsigned* AB = (unsigned*)(ws + WS_R3); bf16_t* QB = (bf16_t*)(ws + WS_R3); bf16_t* GB = QB + (size_t)M * D;
    const int lo = args.ph_lo, hi = args.ph_hi;
#ifdef ONLYPH
#define IN(k) ((k) == ONLYPH && lo <= (k) && (k) < hi)
#else
#define IN(k) (lo <= (k) && (k) < hi)
#endif
#if MK_SINGLE
    volatile LAS unsigned* MISC = (volatile LAS unsigned*)(lds + 131072);
    if (tid < 64) MISC[tid] = 0u;
    __syncthreads();
    const XcdBarrier bar = xcd_barrier_post((unsigned*)ws, MISC + 8);
    cg::this_grid().sync();
#define SEAM(k) do { if (IN(k) && IN((k) + 1)) xcd_barrier(bar); } while (0)
#define SEAM_BAR() xcd_barrier(bar)
#else
#define SEAM(k) do { } while (0)
#define SEAM_BAR() do { } while (0)
#endif

    if (IN(0)) for (int rep_ = 0; rep_ < REPS(0); ++rep_) {
        const float* xp = ARGP(0); const float* xs = ARGP(1); const float* cache_k = ARGP(4); const float* cache_v = ARGP(5); const float* norm_a = ARGP(6); const float* w_in_a = ARGP(7);
        const float* w_gx = ARGP(10); const float* w_ga = ARGP(12); const float* lam = ARGP(14); const float* w_out_a = ARGP(15); const float* norm_kv = ARGP(16); const float* w_kv = ARGP(17);
        const float* norm_b = ARGP(19); const float* w_in_b = ARGP(20); const float* w_out_b = ARGP(23);
        LAS float* scr = (LAS float*)(lds + wave * 16384);
        constexpr int NITEMS = 1024 + 256 + 512 + 1024 + 128 + 512;
        for (int it = gw; it < NITEMS; it += NGW) {
            int r = it;
            if (r < 1024) { transpose_item(w_in_a, 2048, 64, norm_a, WT_INA, 1024, RmId{}, scr, r, lane); continue; } r -= 1024;
            if (r < 256) { const int gm = r >> 5, gi = gm & 3, isA = gm >> 2; transpose_item((isA ? w_ga : w_gx) + (size_t)gi * 65536, 256, 8, nullptr, WT_GATE, 256, RmGate{gi, isA}, scr, r & 31, lane); continue; } r -= 256;
            if (r < 512) { transpose_item(w_out_a, 1024, 32, nullptr, WT_OUTA, 1024, RmId{}, scr, r, lane); continue; } r -= 512;
            if (r < 1024) { transpose_item(w_in_b, 2048, 64, norm_b, WT_B, 1024, RmHead{0}, scr, r, lane); continue; } r -= 1024;
            if (r < 128) { transpose_item(w_kv, 256, 8, norm_kv, WT_B, 1024, RmHead{32}, scr, r, lane); continue; } r -= 128;
            transpose_item(w_out_b, 1024, 32, nullptr, WT_OUTB, 1024, RmId{}, scr, r, lane);
        }
        for (int m = 2 * gw; m < M; m += 2 * NGW) {
            const float* xrow0 = (m < MP) ? xp + (size_t)m * D : xs + (size_t)(m - MP) * D;
            const f32x4* xr0 = (const f32x4*)xrow0 + lane; const f32x4* xr1 = xr0 + 256;
            f32x4 v[4], w[4]; float s0 = 0.f, s1 = 0.f;
#pragma unroll
            for (int j = 0; j < 4; ++j) { v[j] = xr0[64 * j]; w[j] = xr1[64 * j]; }
#pragma unroll
            for (int j = 0; j < 4; ++j) { s0 += (v[j].x * v[j].x + v[j].y * v[j].y) + (v[j].z * v[j].z + v[j].w * v[j].w); s1 += (w[j].x * w[j].x + w[j].y * w[j].y) + (w[j].z * w[j].z + w[j].w * w[j].w); }
            const float rs0 = rsqrtf(wave_sum(s0) * (1.0f / D) + EPS), rs1 = rsqrtf(wave_sum(s1) * (1.0f / D) + EPS);
            v2u* o0 = (v2u*)(XN + (size_t)m * D) + lane; v2u* o1 = o0 + 256;
#pragma unroll
            for (int j = 0; j < 4; ++j) { o0[64 * j] = (v2u){pk2(v[j].x * rs0, v[j].y * rs0), pk2(v[j].z * rs0, v[j].w * rs0)}; o1[64 * j] = (v2u){pk2(w[j].x * rs1, w[j].y * rs1), pk2(w[j].z * rs1, w[j].w * rs1)}; }
        }
        for (int i = gtid; i < M; i += NT) SS[i] = 0.f;
        for (int i = gtid; i < D; i += NT) { const float l = lam[i]; CL[i] = 8.0f * (fminf(l, 0.f) - log1pf(__expf(-fabsf(l)))); }
        for (int i = gtid; i < NBS * 128 * 128; i += NT) { KC[i] = (bf16_t)(pk2(cache_k[i], 0.f) & 0xffffu);
            const int t = i & 127, d = (i >> 7) & 63, h = (i >> 13) & 1, b = i >> 14;
            VTC[i] = (bf16_t)(pk2(cache_v[((size_t)(b * 128 + t) * 2 + h) * 64 + d], 0.f) & 0xffffu); }
        for (int i = gtid; i < NBS * 64 * 128; i += NT) { const int b = i >> 13, rem = i & 8191;
            out[O_KS + (size_t)b * 16384 + rem] = cache_k[(size_t)b * 16384 + 8192 + rem];
            out[O_VS + (size_t)b * 16384 + rem] = cache_v[(size_t)b * 16384 + 8192 + rem]; }
        __syncthreads();
    }
    SEAM(0);

    if (IN(1)) for (int rep_ = 0; rep_ < REPS(1); ++rep_) {
        pg8::Gemm g{XN, WT_INA, M, 2048, 1024, 1024, 1024, 0, 0}; pg8::StaticOrder S; S.init(M, 2048, G, bid);
        EpiStore E{U, 2048};
        pg8::gemm_phase<EpiStore, pg8::StaticOrder, true>(lds, g, S, E);
    }
    SEAM(1);

    if (IN(2)) for (int rep_ = 0; rep_ < REPS(2); ++rep_) {
        const float* state_conv = ARGP(2); const float* conv_w = ARGP(8); const float* conv_b = ARGP(9);
        for (int it = gw; it < (M / 16) * 2; it += NGW) {
            const int row0 = (it >> 1) * 16, c0 = (it & 1) * 512 + lane * 8;
            int t0, T; const float* st = nullptr; float* cso;
            if (row0 < MP) { t0 = row0 & 2047; T = TP; cso = out + O_CONVP + (size_t)(row0 >> 11) * 3 * D; }
            else { const int r = row0 - MP; t0 = r & 63; T = TS; st = state_conv + (size_t)(r >> 6) * 3 * D; cso = out + O_CONVS + (size_t)(r >> 6) * 3 * D; }
            float w[4][8], bb[8], xh[3][8];
#pragma unroll
            for (int e = 0; e < 8; ++e) { bb[e] = conv_b[c0 + e];
#pragma unroll
                for (int j = 0; j < 4; ++j) w[j][e] = conv_w[j * D + c0 + e]; }
#pragma unroll
            for (int j = 0; j < 3; ++j) {
                if (t0 == 0) {
#pragma unroll
                    for (int e = 0; e < 8; ++e) xh[j][e] = st ? st[j * D + c0 + e] : 0.f;
                } else {
                    const v4u q = *(const v4u*)(U + (size_t)(row0 - 3 + j) * 2048 + c0);
                    xh[j][0] = bflo(q.x); xh[j][1] = bfhi(q.x); xh[j][2] = bflo(q.y); xh[j][3] = bfhi(q.y); xh[j][4] = bflo(q.z); xh[j][5] = bfhi(q.z); xh[j][6] = bflo(q.w); xh[j][7] = bfhi(q.w);
                }
            }
#pragma unroll
            for (int r = 0; r < 16; ++r) {
                const v4u q = *(const v4u*)(U + (size_t)(row0 + r) * 2048 + c0);
                float x3[8] = {bflo(q.x), bfhi(q.x), bflo(q.y), bfhi(q.y), bflo(q.z), bfhi(q.z), bflo(q.w), bfhi(q.w)};
                float o[8];
#pragma unroll
                for (int e = 0; e < 8; ++e) o[e] = bb[e] + w[0][e] * xh[0][e] + w[1][e] * xh[1][e] + w[2][e] * xh[2][e] + w[3][e] * x3[e];
                *(v4u*)(XC + (size_t)(row0 + r) * D + c0) = (v4u){pk2(o[0], o[1]), pk2(o[2], o[3]), pk2(o[4], o[5]), pk2(o[6], o[7])};
                if (t0 + r >= T - 3) { float* p = cso + (size_t)(t0 + r - (T - 3)) * D + c0;
                    *(f32x4*)p = (f32x4){x3[0], x3[1], x3[2], x3[3]}; *(f32x4*)(p + 4) = (f32x4){x3[4], x3[5], x3[6], x3[7]}; }
#pragma unroll
                for (int e = 0; e < 8; ++e) { xh[0][e] = xh[1][e]; xh[1][e] = xh[2][e]; xh[2][e] = x3[e]; }
            }
        }
        __syncthreads();
    }
    SEAM(2);

    if (IN(3)) for (int rep_ = 0; rep_ < REPS(3); ++rep_) {
        pg8::Gemm g{XC, WT_GATE, M, 2048, 256, 1024, 256, 1, 256}; pg8::StaticOrder S; S.init(M, 2048, G, bid);
        EpiGate E{XC, ARGP(11), ARGP(13), CL, AB, CP, CH};
        pg8::gemm_phase<EpiGate, pg8::StaticOrder, true, true>(lds, g, S, E);
    }
    if (IN(3) && IN(5)) { SEAM_BAR(); }


    if (IN(5)) for (int rep_ = 0; rep_ < REPS(5); ++rep_) {
        const float* state_h = ARGP(3);
        for (int it = gw; it < (M / 64) * 16; it += NGW) {
            const int uid = it >> 4, c = (it & 15) * 64 + lane;
            int k; float h;
            if (uid < 512) { k = uid & 31; h = 0.f; } else { k = 0; h = state_h[(size_t)(uid - 512) * D + c]; }
            {
                const float* cp0 = CP + (size_t)(uid - k) * D + c; const float* ch0 = CH + (size_t)(uid - k) * D + c;
#pragma unroll 1
                for (int j0 = 0; j0 < k; j0 += 16) {
                    float pa[16], pb[16];
#pragma unroll
                    for (int i = 0; i < 16; ++i) { const bool ok = (j0 + i) < k; pa[i] = ok ? cp0[(size_t)(j0 + i) * D] : 1.0f; pb[i] = ok ? ch0[(size_t)(j0 + i) * D] : 0.0f; }
#pragma unroll
                    for (int i = 0; i < 16; ++i) h = pa[i] * h + pb[i];
                }
            }
            const unsigned* p = AB + (size_t)uid * 64 * D + c;
            const bf16_t* gp = U + (size_t)uid * 64 * 2048 + 1024 + c;
            bf16_t* hp = HG + (size_t)uid * 64 * D + c;
#pragma unroll 1
            for (int r0 = 0; r0 < 64; r0 += 32) {
                unsigned wv[32]; bf16_t gv[32];
#pragma unroll
                for (int i = 0; i < 32; ++i) { wv[i] = p[(size_t)(r0 + i) * D]; gv[i] = gp[(size_t)(r0 + i) * 2048]; }
#pragma unroll
                for (int i = 0; i < 32; ++i) { const float la = (float)__builtin_bit_cast(_Float16, (unsigned short)(wv[i] & 0xffffu)); const float a = __expf(la);
                    h = a * h + bfhi(wv[i]); const float gt = bf2f(gv[i]); const float hg = h * gt * sigmoidf_(gt);
                    hp[(size_t)(r0 + i) * D] = (bf16_t)(pk2(hg, hg) & 0xffffu); }
            }
            if (uid >= 512) out[O_HS + (size_t)(uid - 512) * D + c] = h;
            else if (k == 31) out[O_HP + (size_t)(uid >> 5) * D + c] = h;
        }
        __syncthreads();
    }
    SEAM(5);

    if (IN(6)) for (int rep_ = 0; rep_ < REPS(6); ++rep_) {
        pg8::Gemm g{HG, WT_OUTA, M, 1024, 1024, 1024, 1024, 0, 0}; pg8::StaticOrder S; S.init(M, 1024, G, bid);
        EpiOutA E{ARGP(0), ARGP(1), X1B, SS};
        pg8::gemm_phase<EpiOutA, pg8::StaticOrder, true>(lds, g, S, E);
    }
    SEAM(6);

    if (IN(7)) for (int rep_ = 0; rep_ < REPS(7); ++rep_) {
        pg8::Gemm g{X1B, WT_B, M, 2304, 1024, 1024, 1024, 0, 0}; pg8::StaticOrder S; S.init(M, 2304, G, bid);
        EpiB E{SS, ARGP(21), ARGP(18), QB, GB, KB, VTP, VTS, out};
        pg8::gemm_phase<EpiB, pg8::StaticOrder, true>(lds, g, S, E);
    }
    SEAM(7);

    if (IN(8)) for (int rep_ = 0; rep_ < REPS(8); ++rep_) {
        const float* sinks = ARGP(22);
        const int i16 = lane & 15, g4 = lane >> 4;
        constexpr int KP = 144, VP = 400, KBYTES = 192 * KP, BUFB = KBYTES + 64 * VP;
        const int rl = tid >> 3, c8 = tid & 7;
        const int kk_s = 32 * (rl >> 5) + 8 * ((rl & 15) >> 2) + (rl & 3) + 4 * ((rl >> 4) & 1);
        const int ksrc = kk_s * 128 + 8 * c8, kdst = rl * KP + 16 * c8, vdst = KBYTES + rl * VP + 16 * c8;
        int row0, kvh; const bf16_t* kp[3]; const bf16_t* vp[3]; int vpitch[3]; bool valid[3];
        v4u kreg[3], vreg[3]; bf16x8 qn[4][2];
#define ATT_DESC(u_) do { if ((u_) < 1024) { const int s_ = (u_) >> 6, c_ = ((u_) >> 1) & 31; kvh = (u_) & 1; row0 = s_ * TP + 64 * c_; \
            _Pragma("unroll") for (int jb = 0; jb < 3; ++jb) { const int cc = c_ - 2 + jb; valid[jb] = cc >= 0; const int ccc = cc < 0 ? 0 : cc; \
                kp[jb] = KB + (size_t)(s_ * TP + 64 * ccc) * 128 + kvh * 64; vp[jb] = VTP + (size_t)((s_ * 2 + kvh) * 64) * TP + 64 * ccc; vpitch[jb] = TP; } \
        } else { const int u2 = (u_) - 1024, b_ = u2 >> 1; kvh = u2 & 1; row0 = MP + 64 * b_; \
            _Pragma("unroll") for (int jb = 0; jb < 2; ++jb) { valid[jb] = true; kp[jb] = KC + (size_t)(b_ * 128 + 64 * jb) * 128 + kvh * 64; vp[jb] = VTC + (size_t)((b_ * 2 + kvh) * 64) * 128 + 64 * jb; vpitch[jb] = 128; } \
            valid[2] = true; kp[2] = KB + (size_t)(MP + 64 * b_) * 128 + kvh * 64; vp[2] = VTS + (size_t)((b_ * 2 + kvh) * 64) * TS; vpitch[2] = TS; } } while (0)
#define ATT_LOAD() do { _Pragma("unroll") for (int jb = 0; jb < 3; ++jb) if (valid[jb]) { kreg[jb] = *(const v4u*)(kp[jb] + ksrc); vreg[jb] = *(const v4u*)(vp[jb] + (size_t)rl * vpitch[jb] + 8 * c8); } \
            _Pragma("unroll") for (int qt = 0; qt < 4; ++qt) { const size_t qoff = (size_t)(row0 + 16 * qt + i16) * D + (kvh * 8 + wave) * 64 + 8 * g4; \
                qn[qt][0] = *(const bf16x8*)(QB + qoff); qn[qt][1] = *(const bf16x8*)(QB + qoff + 32); } } while (0)
        int u = bid, buf = 0;
        if (u < 1088) { ATT_DESC(u); ATT_LOAD(); }
        for (; u < 1088; u += G) {
            LAS unsigned char* L = lds + buf * BUFB;
#pragma unroll
            for (int jb = 0; jb < 3; ++jb) if (valid[jb]) { *(LAS v4u*)(L + jb * 64 * KP + kdst) = kreg[jb]; *(LAS v4u*)(L + vdst + jb * 128) = vreg[jb]; }
            const int row0c = row0, qh = kvh * 8 + wave; const bool v0 = valid[0], v1 = valid[1];
            bf16x8 qf[4][2];
#pragma unroll
            for (int qt = 0; qt < 4; ++qt) { qf[qt][0] = qn[qt][0]; qf[qt][1] = qn[qt][1]; }
            __syncthreads();
            const int un = u + G;
            if (un < 1088) { ATT_DESC(un); ATT_LOAD(); }
            const float sk = sinks[qh];
#pragma unroll
            for (int qt = 0; qt < 4; ++qt) {
                const size_t ooff = (size_t)(row0c + 16 * qt + i16) * D + qh * 64 + 4 * g4;
                v2u gw2[4];
#pragma unroll
                for (int dt = 0; dt < 4; ++dt) gw2[dt] = *(const v2u*)(GB + ooff + 16 * dt);
                f32x4 s[12];
#pragma unroll
                for (int jb = 0; jb < 3; ++jb) {
                    const bool ok = (jb == 0) ? v0 : ((jb == 1) ? v1 : true);
                    if (ok) {
#pragma unroll
                        for (int q2 = 0; q2 < 4; ++q2) {
                            const LAS unsigned char* ka = L + (64 * jb + 16 * q2 + i16) * KP + 16 * g4;
                            const bf16x8 a0 = *(const LAS bf16x8*)ka, a1 = *(const LAS bf16x8*)(ka + 64);
                            f32x4 ac = (f32x4){0.f, 0.f, 0.f, 0.f};
                            ac = __builtin_amdgcn_mfma_f32_16x16x32_bf16(a0, qf[qt][0], ac, 0, 0, 0);
                            ac = __builtin_amdgcn_mfma_f32_16x16x32_bf16(a1, qf[qt][1], ac, 0, 0, 0);
                            s[4 * jb + q2] = ac; }
                    } else {
#pragma unroll
                        for (int q2 = 0; q2 < 4; ++q2) s[4 * jb + q2] = (f32x4){-1e30f, -1e30f, -1e30f, -1e30f};
                    }
                }
                float mx = sk;
#pragma unroll
                for (int kt = 0; kt < 12; ++kt) mx = fmaxf(fmaxf(mx, fmaxf(s[kt][0], s[kt][1])), fmaxf(s[kt][2], s[kt][3]));
                mx = fmaxf(mx, __shfl_xor(mx, 16)); mx = fmaxf(mx, __shfl_xor(mx, 32));
                float sum = 0.f;
#pragma unroll
                for (int kt = 0; kt < 12; ++kt) {
#pragma unroll
                    for (int r = 0; r < 4; ++r) { const float pv = __expf(s[kt][r] - mx); s[kt][r] = pv; sum += pv; } }
                sum += __shfl_xor(sum, 16); sum += __shfl_xor(sum, 32);
                const float inv = 1.0f / (sum + __expf(sk - mx));
                bf16x8 pf[6];
#pragma unroll
                for (int kb = 0; kb < 6; ++kb) { const f32x4 p0 = s[2 * kb] * inv, p1 = s[2 * kb + 1] * inv;
                    const v4u w = (v4u){pk2(p0[0], p0[1]), pk2(p0[2], p0[3]), pk2(p1[0], p1[1]), pk2(p1[2], p1[3])};
                    pf[kb] = __builtin_bit_cast(bf16x8, w); }
#pragma unroll
                for (int dt = 0; dt < 4; ++dt) {
                    f32x4 oc = (f32x4){0.f, 0.f, 0.f, 0.f};
#pragma unroll
                    for (int jb = 0; jb < 3; ++jb) {
                        const bool ok = (jb == 0) ? v0 : ((jb == 1) ? v1 : true);
                        if (ok) {
#pragma unroll
                            for (int sb = 0; sb < 2; ++sb) {
                                const bf16x8 vf = *(const LAS bf16x8*)(L + KBYTES + (16 * dt + i16) * VP + (64 * jb + 32 * sb + 8 * g4) * 2);
                                oc = __builtin_amdgcn_mfma_f32_16x16x32_bf16(vf, pf[2 * jb + sb], oc, 0, 0, 0); }
                        }
                    }
                    *(v2u*)(HG + ooff + 16 * dt) = (v2u){pk2(oc[0] * bflo(gw2[dt].x), oc[1] * bfhi(gw2[dt].x)), pk2(oc[2] * bflo(gw2[dt].y), oc[3] * bfhi(gw2[dt].y))};
                }
                __builtin_amdgcn_sched_barrier(0);
            }
            buf ^= 1;
        }
#undef ATT_DESC
#undef ATT_LOAD
        __syncthreads();
    }
    SEAM(8);

    if (IN(9)) for (int rep_ = 0; rep_ < REPS(9); ++rep_) {
        pg8::Gemm g{HG, WT_OUTB, M, 1024, 1024, 1024, 1024, 0, 0}; pg8::StaticOrder S; S.init(M, 1024, G, bid);
        EpiOutB E{X1B, out + O_Y};
        pg8::gemm_phase<EpiOutB, pg8::StaticOrder, true>(lds, g, S, E);
    }
#undef IN
#undef SEAM
}

extern "C" void kernel_launch(void* const* d_in, const int* in_sizes, int n_in, void* d_out, int out_size, void* d_ws, size_t ws_size, hipStream_t stream) {
    static int grid = 0;
    if (grid == 0) {
        if (n_in != 24 || ws_size < WS_END) { fprintf(stderr, "kernel_launch: unexpected n_in %d / ws %zu\n", n_in, ws_size); grid = -1; return; }
        int dev = 0, cus = 0, per_cu = 0;
        (void)hipGetDevice(&dev);
        (void)hipDeviceGetAttribute(&cus, hipDeviceAttributeMultiprocessorCount, dev);
        if (hipFuncSetAttribute((const void*)yoco_fwd, hipFuncAttributeMaxDynamicSharedMemorySize, LDS_BYTES) != hipSuccess) { fprintf(stderr, "kernel_launch: hipFuncSetAttribute failed\n"); }
        if (hipOccupancyMaxActiveBlocksPerMultiprocessor(&per_cu, (const void*)yoco_fwd, 512, LDS_BYTES) != hipSuccess || per_cu < 1) { fprintf(stderr, "kernel_launch: occupancy query gave %d\n", per_cu); per_cu = 1; }
        (void)hipGetLastError();
        if (per_cu > 1) per_cu = 1;
        grid = cus * per_cu;
    }
    if (grid < 0) return;
    Args a{};
    for (int i = 0; i < 24; ++i) a.in[i] = (const float*)d_in[i];
    a.out = (float*)d_out; a.ws = (unsigned char*)d_ws;
#if MK_SINGLE
    if (hipMemsetAsync(d_ws, 0, 16384, stream) != hipSuccess) { fprintf(stderr, "kernel_launch: memset of the barrier words failed\n"); return; }
    a.ph_lo = 0; a.ph_hi = NPH;
    void* kargs[] = {&a};
    hipError_t e = hipLaunchCooperativeKernel((const void*)yoco_fwd, dim3(grid), dim3(512), kargs, LDS_BYTES, stream);
    if (e != hipSuccess) fprintf(stderr, "cooperative launch failed: %s (grid %d)\n", hipGetErrorString(e), grid);
#else
    for (int ph = 0; ph < NPH; ++ph) {
        a.ph_lo = ph; a.ph_hi = ph + 1;
        hipLaunchKernelGGL(yoco_fwd, dim3(grid), dim3(512), LDS_BYTES, stream, a);
    }
#endif
}
```
